# Optimizing an MI355X kernel written in HIP

```python
import math
import jax, jax.numpy as jnp
from jax import lax
import numpy as np

D_MODEL = 1024
BATCH = 4
SEQ = 4096
DEPTH = 1
DEC_BATCH = 32
DEC_SEQ = 1
PAST_LEN = 8192
PAGE_SIZE = 128

N_HEADS = 8
HEAD_DIM = 64
ATTN_WIDTH = N_HEADS * HEAD_DIM
MOBA_BLOCK = 256
MOBA_TOPK = 3
Q_CHUNK = 16
ROPE_THETA = 10000.0
SSM_WIDTH = D_MODEL // 2
SSM_GROUP = 16
SSM_GROUPS = SSM_WIDTH // SSM_GROUP
SSM_STATE = 64
DT_MIN = 1e-3
DT_MAX = 1e-1
FFN_HIDDEN = ((8 * D_MODEL + 3 * 256 - 1) // (3 * 256)) * 256
IN_WIDTH = 3 * ATTN_WIDTH + SSM_WIDTH + 2 * D_MODEL
RMS_EPS = 1e-6

kernel_name = 'moba_s5_gated_hybrid_step'

F32 = jnp.float32


def rmsnorm(x, g):
    xf = x.astype(F32)
    y = xf * lax.rsqrt(jnp.mean(xf * xf, axis=-1, keepdims=True) + RMS_EPS)
    return (y * g.astype(F32)).astype(x.dtype)


def rotary(x, pos):
    half = HEAD_DIM // 2
    inv = jnp.power(jnp.float32(ROPE_THETA), -2.0 * jnp.arange(half, dtype=F32) / HEAD_DIM)
    ang = pos.astype(F32)[:, None] * inv[None, :]
    cos = jnp.cos(ang)[None, :, None, :]
    sin = jnp.sin(ang)[None, :, None, :]
    xf = x.astype(F32)
    x1, x2 = xf[..., :half], xf[..., half:]
    return jnp.concatenate([x1 * cos - x2 * sin, x2 * cos + x1 * sin], axis=-1).astype(x.dtype)


def to_blocks(k, v):
    b, L = k.shape[:2]
    nb = -(-L // MOBA_BLOCK)
    pad = nb * MOBA_BLOCK - L
    kb = jnp.pad(k, ((0, 0), (0, pad), (0, 0), (0, 0))).reshape(b, nb, MOBA_BLOCK, N_HEADS, HEAD_DIM)
    vb = jnp.pad(v, ((0, 0), (0, pad), (0, 0), (0, 0))).reshape(b, nb, MOBA_BLOCK, N_HEADS, HEAD_DIM)
    k_mean = jnp.mean(kb, axis=2, dtype=F32)
    return kb, vb, k_mean


def moba_attend(q, kb, vb, k_mean, q_pos):
    bsz, nq = q.shape[:2]
    nb = kb.shape[1]
    q_blk = q_pos // MOBA_BLOCK
    qf = q.astype(F32)
    s_blk = jnp.einsum('bqhd,bnhd->bhqn', qf, k_mean)
    fully_past = jnp.arange(nb)[None, :] < q_blk[:, None]
    s_blk = jnp.where(fully_past[None, None], s_blk, -jnp.inf)
    n_sel = min(MOBA_TOPK, nb)
    _, top_idx = lax.top_k(s_blk, n_sel)
    own = jnp.broadcast_to(q_blk[None, None, :, None], (bsz, N_HEADS, nq, 1)).astype(top_idx.dtype)
    idx = jnp.concatenate([top_idx, own], axis=-1)
    slot_ok = jnp.concatenate([jnp.arange(n_sel)[None, :] < q_blk[:, None],
                               jnp.ones((nq, 1), dtype=bool)], axis=-1)
    bi = jnp.arange(bsz)[:, None, None, None]
    hi = jnp.arange(N_HEADS)[None, :, None, None]
    kg = kb[bi, idx, :, hi, :]
    vg = vb[bi, idx, :, hi, :]
    key_pos = idx[..., None] * MOBA_BLOCK + jnp.arange(MOBA_BLOCK)
    mask = slot_ok[None, None, :, :, None] & (key_pos <= q_pos[None, None, :, None, None])
    s = jnp.einsum('bqhd,bhqnkd->bhqnk', q, kg, preferred_element_type=F32) * (HEAD_DIM ** -0.5)
    s = jnp.where(mask, s, -jnp.inf)
    p = jax.nn.softmax(s.reshape(bsz, N_HEADS, nq, -1), axis=-1).reshape(s.shape)
    o = jnp.einsum('bhqnk,bhqnkd->bqhd', p.astype(vg.dtype), vg, preferred_element_type=F32)
    return o.astype(q.dtype)


def prompt_attend(q, k, v, pos):
    bsz, L = q.shape[:2]
    kb, vb, km = to_blocks(k, v)
    nc = L // Q_CHUNK
    qc = q.reshape(bsz, nc, Q_CHUNK, N_HEADS, HEAD_DIM).swapaxes(0, 1)
    pc = pos.reshape(nc, Q_CHUNK)
    o = lax.map(lambda a: moba_attend(a[0], kb, vb, km, a[1]), (qc, pc))
    return o.swapaxes(0, 1).reshape(bsz, L, N_HEADS, HEAD_DIM)


def s5_scan(u, h0, a_re, a_im, log_dt, b_re, b_im, c_re, c_im, d):
    bsz, L = u.shape[:2]
    uf = u.astype(F32).reshape(bsz, L, SSM_GROUPS, SSM_GROUP)
    lam = lax.complex(a_re.astype(F32), a_im.astype(F32))
    dt = jnp.exp(log_dt.astype(F32))[:, None]
    a_bar = jnp.exp(lam * dt)
    b_c = lax.complex(b_re.astype(F32), b_im.astype(F32))
    b_bar = ((a_bar - 1.0) / lam)[..., None] * b_c
    c_c = lax.complex(c_re.astype(F32), c_im.astype(F32))
    bu = jnp.einsum('gpc,blgc->blgp', b_bar, uf.astype(jnp.complex64))
    bu = bu.at[:, 0].add(a_bar[None] * h0)
    a_seq = jnp.broadcast_to(a_bar, bu.shape)

    def combine(e1, e2):
        return (e2[0] * e1[0], e2[0] * e1[1] + e2[1])

    _, h = lax.associative_scan(combine, (a_seq, bu), axis=1)
    y = jnp.einsum('gcp,blgp->blgc', c_c, h).real + d.astype(F32).reshape(SSM_GROUPS, SSM_GROUP) * uf
    return y.reshape(bsz, L, SSM_WIDTH).astype(u.dtype), h[:, -1]


def trunk_layer(x, pos, attend, h0, lp):
    bsz, L = x.shape[:2]
    h = rmsnorm(x, lp['norm_mix'])
    proj = h @ lp['w_in']
    cuts = [ATTN_WIDTH, 2 * ATTN_WIDTH, 3 * ATTN_WIDTH, 3 * ATTN_WIDTH + SSM_WIDTH,
            3 * ATTN_WIDTH + SSM_WIDTH + D_MODEL]
    q, k, v, u, g_attn, g_ssm = jnp.split(proj, cuts, axis=-1)
    q = rotary(q.reshape(bsz, L, N_HEADS, HEAD_DIM), pos)
    k = rotary(k.reshape(bsz, L, N_HEADS, HEAD_DIM), pos)
    v = v.reshape(bsz, L, N_HEADS, HEAD_DIM)
    o = attend(q, k, v, pos)
    attn_out = o.reshape(bsz, L, ATTN_WIDTH) @ lp['w_attn_proj']
    y, h_last = s5_scan(u, h0, lp['a_re'], lp['a_im'], lp['log_dt'], lp['b_re'], lp['b_im'],
                        lp['c_re'], lp['c_im'], lp['d'])
    z = jax.nn.gelu(y)
    z = z * jax.nn.sigmoid(z @ lp['w_glu'] + lp['b_glu'])
    ssm_out = z @ lp['w_ssm_proj']
    merged = jax.nn.sigmoid(g_attn) * attn_out + jax.nn.sigmoid(g_ssm) * ssm_out
    x = x + merged @ lp['w_out']
    hf = rmsnorm(x, lp['norm_ffn'])
    a, g = jnp.split(hf @ lp['w_ffn_in'], 2, axis=-1)
    x = x + (jax.nn.silu(a) * g) @ lp['w_ffn_out']
    return x, k, v, h_last


def setup_inputs(seed: int = 0) -> dict:
    key = jax.random.key(seed)
    ks = jax.random.split(key, 32)
    n_pages = PAST_LEN // PAGE_SIZE
    n_used = DEC_BATCH * n_pages
    n_phys = n_used + (n_used + 3) // 4

    def nrm(k, shape, scale):
        return jax.random.normal(k, shape, F32) * scale

    n_idx = jnp.arange(SSM_STATE, dtype=F32)
    return {
        'x_prompt': nrm(ks[0], (BATCH, SEQ, D_MODEL), 1.0),
        'x_sample': nrm(ks[1], (DEC_BATCH, DEC_SEQ, D_MODEL), 1.0),
        'cache_k': nrm(ks[2], (DEPTH, n_phys, PAGE_SIZE, N_HEADS, HEAD_DIM), 1.0),
        'cache_v': nrm(ks[3], (DEPTH, n_phys, PAGE_SIZE, N_HEADS, HEAD_DIM), 1.0),
        'state_ssm_re': nrm(ks[4], (DEPTH, DEC_BATCH, SSM_GROUPS, SSM_STATE), 0.5),
        'state_ssm_im': nrm(ks[5], (DEPTH, DEC_BATCH, SSM_GROUPS, SSM_STATE), 0.5),
        'page_table': jax.random.permutation(ks[6], n_phys)[:n_used].reshape(DEC_BATCH, n_pages).astype(jnp.int32),
        'norm_mix': 1.0 + nrm(ks[7], (DEPTH, D_MODEL), 0.02),
        'w_in': nrm(ks[8], (DEPTH, D_MODEL, IN_WIDTH), D_MODEL ** -0.5),
        'w_attn_proj': nrm(ks[9], (DEPTH, ATTN_WIDTH, D_MODEL), ATTN_WIDTH ** -0.5),
        'ssm_a_re': -0.5 + nrm(ks[10], (DEPTH, SSM_GROUPS, SSM_STATE), 0.01),
        'ssm_a_im': math.pi * n_idx + nrm(ks[11], (DEPTH, SSM_GROUPS, SSM_STATE), 0.01),
        'ssm_log_dt': jax.random.uniform(ks[12], (DEPTH, SSM_GROUPS), F32, math.log(DT_MIN), math.log(DT_MAX)),
        'ssm_b_re': nrm(ks[13], (DEPTH, SSM_GROUPS, SSM_STATE, SSM_GROUP), (2 * SSM_GROUP) ** -0.5),
        'ssm_b_im': nrm(ks[14], (DEPTH, SSM_GROUPS, SSM_STATE, SSM_GROUP), (2 * SSM_GROUP) ** -0.5),
        'ssm_c_re': nrm(ks[15], (DEPTH, SSM_GROUPS, SSM_GROUP, SSM_STATE), (2 * SSM_STATE) ** -0.5),
        'ssm_c_im': nrm(ks[16], (DEPTH, SSM_GROUPS, SSM_GROUP, SSM_STATE), (2 * SSM_STATE) ** -0.5),
        'ssm_d': nrm(ks[17], (DEPTH, SSM_WIDTH), 1.0),
        'w_glu': nrm(ks[18], (DEPTH, SSM_WIDTH, SSM_WIDTH), SSM_WIDTH ** -0.5),
        'b_glu': nrm(ks[19], (DEPTH, SSM_WIDTH), 0.01),
        'w_ssm_proj': nrm(ks[20], (DEPTH, SSM_WIDTH, D_MODEL), SSM_WIDTH ** -0.5),
        'w_out': nrm(ks[21], (DEPTH, D_MODEL, D_MODEL), D_MODEL ** -0.5),
        'norm_ffn': 1.0 + nrm(ks[22], (DEPTH, D_MODEL), 0.02),
        'w_ffn_in': nrm(ks[23], (DEPTH, D_MODEL, 2 * FFN_HIDDEN), D_MODEL ** -0.5),
        'w_ffn_out': nrm(ks[24], (DEPTH, FFN_HIDDEN, D_MODEL), FFN_HIDDEN ** -0.5),
        'norm_final': 1.0 + nrm(ks[25], (D_MODEL,), 0.02),
    }


def reference(x_prompt, x_sample, cache_k, cache_v, state_ssm_re, state_ssm_im, page_table,
              norm_mix, w_in, w_attn_proj, ssm_a_re, ssm_a_im, ssm_log_dt, ssm_b_re, ssm_b_im,
              ssm_c_re, ssm_c_im, ssm_d, w_glu, b_glu, w_ssm_proj, w_out, norm_ffn,
              w_ffn_in, w_ffn_out, norm_final):
    n_prompt, seq = x_prompt.shape[:2]
    n_seq, dec_seq = x_sample.shape[:2]
    pos_p = jnp.arange(seq, dtype=jnp.int32)
    pos_s = PAST_LEN + jnp.arange(dec_seq, dtype=jnp.int32)
    h0_prompt = jnp.zeros((n_prompt, SSM_GROUPS, SSM_STATE), jnp.complex64)

    xp, xs = x_prompt, x_sample
    kp_l, vp_l, rp_l, ip_l, ks_l, vs_l, rs_l, is_l = [], [], [], [], [], [], [], []
    for l in range(DEPTH):
        lp = dict(norm_mix=norm_mix[l], w_in=w_in[l], w_attn_proj=w_attn_proj[l],
                  a_re=ssm_a_re[l], a_im=ssm_a_im[l], log_dt=ssm_log_dt[l],
                  b_re=ssm_b_re[l], b_im=ssm_b_im[l], c_re=ssm_c_re[l], c_im=ssm_c_im[l],
                  d=ssm_d[l], w_glu=w_glu[l], b_glu=b_glu[l], w_ssm_proj=w_ssm_proj[l],
                  w_out=w_out[l], norm_ffn=norm_ffn[l], w_ffn_in=w_ffn_in[l], w_ffn_out=w_ffn_out[l])

        xp, kp, vp, hp = trunk_layer(xp, pos_p, prompt_attend, h0_prompt, lp)

        past_k = cache_k[l][page_table].reshape(n_seq, -1, N_HEADS, HEAD_DIM)
        past_v = cache_v[l][page_table].reshape(n_seq, -1, N_HEADS, HEAD_DIM)

        def sample_attend(q, k, v, pos, past_k=past_k, past_v=past_v):
            k_all = jnp.concatenate([past_k.astype(k.dtype), k], axis=1)
            v_all = jnp.concatenate([past_v.astype(v.dtype), v], axis=1)
            kb, vb, km = to_blocks(k_all, v_all)
            return moba_attend(q, kb, vb, km, pos)

        h0_s = lax.complex(state_ssm_re[l].astype(F32), state_ssm_im[l].astype(F32))
        xs, ks_new, vs_new, hs = trunk_layer(xs, pos_s, sample_attend, h0_s, lp)

        kp_l.append(kp); vp_l.append(vp); rp_l.append(hp.real); ip_l.append(hp.imag)
        ks_l.append(ks_new); vs_l.append(vs_new); rs_l.append(hs.real); is_l.append(hs.imag)

    y_prompt = rmsnorm(xp, norm_final)
    y_sample = rmsnorm(xs, norm_final)
    new_k_prompt = jnp.stack(kp_l)
    new_v_prompt = jnp.stack(vp_l)
    new_ssm_re_prompt = jnp.stack(rp_l)
    new_ssm_im_prompt = jnp.stack(ip_l)
    new_k_sample = jnp.stack(ks_l)
    new_v_sample = jnp.stack(vs_l)
    new_ssm_re_sample = jnp.stack(rs_l)
    new_ssm_im_sample = jnp.stack(is_l)
    return (y_prompt, y_sample, new_k_prompt, new_v_prompt, new_ssm_re_prompt, new_ssm_im_prompt,
            new_k_sample, new_v_sample, new_ssm_re_sample, new_ssm_im_sample)
```

```cpp
#include <hip/hip_runtime.h>
#include <cstdio>
#include <cstdint>
namespace pg8 {
#define PG8_LAS __attribute__((address_space(3)))
typedef unsigned short bf16_t;
typedef short bf16x8 __attribute__((ext_vector_type(8)));
typedef float f32x4 __attribute__((ext_vector_type(4)));
typedef unsigned u32x4 __attribute__((ext_vector_type(4)));
constexpr int BM = 256, BK = 64, HALF = 128, HTB = HALF * BK * 2  , STAGE_BYTES = 8 * HTB, NXCD = 8, WGM = 8;

__host__ __device__ __forceinline__ int lds_byte(int r, int c) { const int st = (r >> 4) * 2 + (c >> 5), rr = r & 15, cc = c & 31, ob = rr * 64 + cc * 2; return st * 1024 + (ob ^ (((ob >> 9) & 1) << 5)); }
__host__ __device__ __forceinline__ void stage_rc(int b, int& R, int& C) { const int st = b / 1024, sb = b % 1024, swz = sb ^ (((sb >> 9) & 1) << 5); R = (st >> 1) * 16 + swz / 64; C = (st & 1) * 32 + (swz % 64) / 2; }
__host__ __device__ __forceinline__ int perm32(int rho) { const int n = rho >> 4, i = rho & 15; return 8 * (i >> 2) + 4 * n + (i & 3); }

struct Unit { int pm, pn; };
struct Gemm { const bf16_t* A; const bf16_t* Bt; int M, N, K; };

struct StaticOrder {
    int nM, nN, nwg, G, c;
    __host__ __device__ void init(int M, int N, int G_, int c_) { nM = M / BM; nN = N / BM; nwg = nM * nN; G = G_; c = c_; }
    __host__ __device__ bool next(int i, Unit& u) const {
        const long L = (long)i * G + c; if (L >= nwg) return false;
        int wgid = (int)L; { const int q = nwg / NXCD, r = nwg % NXCD, xcd = wgid % NXCD, off = wgid / NXCD; wgid = (xcd < r ? xcd * (q + 1) : r * (q + 1) + (xcd - r) * q) + off; }
        const int nig = WGM * nN, gid = wgid / nig, fm = gid * WGM, gsz = (nM - fm) < WGM ? (nM - fm) : WGM;
        u.pm = fm + ((wgid % nig) % gsz); u.pn = (wgid % nig) / gsz; return true;
    }
    __device__ __forceinline__ void a_ready(const Unit&) const {}
    __device__ __forceinline__ void done(const Unit&) const {}
};

__device__ __forceinline__ unsigned cvt_pk_bf16(float lo, float hi) { unsigned r; asm volatile("v_cvt_pk_bf16_f32 %0, %1, %2" : "=v"(r) : "v"(lo), "v"(hi)); return r; }
typedef float f32x2 __attribute__((ext_vector_type(2)));
template <class Epi, class Sched, bool ALIGN_EPI = false, bool SP2 = false>
__device__ __forceinline__ void gemm_phase(PG8_LAS unsigned char* lds, const Gemm g, const Sched& S, const Epi& E) {
    int tid_ = threadIdx.x; asm volatile("" : "+v"(tid_));
    const int tid = tid_, wid = __builtin_amdgcn_readfirstlane(tid >> 6), lane = tid & 63, wr = wid >> 2, wc = wid & 3, fr = lane & 15, fq = lane >> 4;
    const int K = g.K, nt = K / BK;
    unsigned voffA[2], voffB[2];
#pragma unroll
    for (int i = 0; i < 2; ++i) { int R, C; stage_rc(tid * 16 + i * 8192, R, C); const int Rb = Epi::PERM ? ((R & ~31) + perm32(R & 31)) : R;
        voffA[i] = (unsigned)(R * K + C) * 2u; voffB[i] = (unsigned)(Rb * K + C) * 2u; }
    const size_t kstep = (size_t)(BK * 2);
    const size_t hstep = (size_t)HALF * K * 2;
    const size_t tstep = 2 * hstep;
    const unsigned ldsw = (unsigned)wid * 1024u;
    const int aoff = lds_byte(wr * 64 + fr, fq * 8), boff = lds_byte(wc * 32 + fr, fq * 8);
#define PG8_SA(b, h) (((b) * 2 + (h)) * HTB)
#define PG8_SB(b, h) ((4 + (b) * 2 + (h)) * HTB)
#define PG8_STAGE(bufoff, gbase, voff) do { _Pragma("unroll") for (int _i = 0; _i < 2; ++_i) \
        __builtin_amdgcn_global_load_lds((const unsigned*)((const char*)(gbase) + (voff)[_i]), (PG8_LAS unsigned*)(lds + (bufoff) + ldsw + _i * 8192), 16, 0, 0); } while (0)
#define PG8_LDA(dst, b, h) do { _Pragma("unroll") for (int m = 0; m < 4; ++m) _Pragma("unroll") for (int k = 0; k < 2; ++k) dst[m][k] = *(const PG8_LAS bf16x8*)(lds + PG8_SA(b, h) + aoff + m * 2048 + k * 1024); } while (0)
#define PG8_LDB(dst, b, h) do { _Pragma("unroll") for (int n = 0; n < 2; ++n) _Pragma("unroll") for (int k = 0; k < 2; ++k) dst[n][k] = *(const PG8_LAS bf16x8*)(lds + PG8_SB(b, h) + boff + n * 2048 + k * 1024); } while (0)
#define PG8_MMA(ai, bj, At, Bt) do { __builtin_amdgcn_s_setprio(1); _Pragma("unroll") for (int m = 0; m < 4; ++m) _Pragma("unroll") for (int n = 0; n < 2; ++n) _Pragma("unroll") for (int k = 0; k < 2; ++k) \
        acc[ai][bj][m][n] = __builtin_amdgcn_mfma_f32_16x16x32_bf16(Bt[n][k], At[m][k], acc[ai][bj][m][n], 0, 0, 0); __builtin_amdgcn_s_setprio(0); } while (0)
#define PG8_WAIT_V(n) asm volatile("s_waitcnt vmcnt(" #n ")" ::: "memory")
#define PG8_WAIT_L(n) asm volatile("s_waitcnt lgkmcnt(" #n ")" ::: "memory")
#define PG8_BAR __builtin_amdgcn_s_barrier()
#define PG8_SCHED __builtin_amdgcn_sched_barrier(0)
    Unit cur, nxt; int ui = 0;
    if (!S.next(0, cur)) return;
    f32x4 acc[2][2][4][2];
#pragma unroll
    for (int a = 0; a < 2; ++a)
#pragma unroll
        for (int b = 0; b < 2; ++b)
#pragma unroll
            for (int m = 0; m < 4; ++m)
#pragma unroll
                for (int n = 0; n < 2; ++n) acc[a][b][m][n] = (f32x4){0.f, 0.f, 0.f, 0.f};
    bf16x8 At[4][2], B0[2][2], B1[2][2];
    const char* cA = (const char*)g.A + (size_t)cur.pm * tstep; const char* cB = (const char*)g.Bt + (size_t)cur.pn * tstep;
    S.a_ready(cur);
    if constexpr (SP2) {
        PG8_STAGE(PG8_SB(0, 0), cB, voffB); PG8_STAGE(PG8_SB(0, 1), cB + hstep, voffB); PG8_STAGE(PG8_SA(0, 0), cA, voffA); PG8_STAGE(PG8_SA(0, 1), cA + hstep, voffA);
        if (wr == 1) PG8_BAR;
        PG8_WAIT_V(2); PG8_BAR;
        PG8_STAGE(PG8_SB(1, 0), cB + kstep, voffB); PG8_STAGE(PG8_SA(1, 0), cA + kstep, voffA); PG8_STAGE(PG8_SB(1, 1), cB + hstep + kstep, voffB);
        PG8_WAIT_V(6); PG8_BAR;
    } else {
        PG8_STAGE(PG8_SB(0, 0), cB, voffB); PG8_STAGE(PG8_SA(0, 0), cA, voffA); PG8_STAGE(PG8_SB(0, 1), cB + hstep, voffB); PG8_STAGE(PG8_SA(0, 1), cA + hstep, voffA);
        if (wr == 1) PG8_BAR;
        PG8_WAIT_V(4); PG8_BAR;
        PG8_STAGE(PG8_SB(1, 0), cB + kstep, voffB); PG8_STAGE(PG8_SA(1, 0), cA + kstep, voffA); PG8_STAGE(PG8_SB(1, 1), cB + hstep + kstep, voffB);
        PG8_WAIT_V(6); PG8_BAR;
    }
    for (;;) {
        const bool has_next = S.next(ui + 1, nxt);
        const char* nA = has_next ? (const char*)g.A + (size_t)nxt.pm * tstep : cA; const char* nB = has_next ? (const char*)g.Bt + (size_t)nxt.pn * tstep : cB;
        for (int t = 0; t < nt; t += 2) {
            const bool last = (t == nt - 2);
            const char* a1 = cA + (size_t)(t + 1) * kstep;
            const char* a2 = last ? nA : cA + (size_t)(t + 2) * kstep; const char* b2 = last ? nB : cB + (size_t)(t + 2) * kstep;
            const char* a3 = a2 + kstep; const char* b3 = b2 + kstep;
            if (last && has_next) S.a_ready(nxt);
            if constexpr (SP2) {
            PG8_LDB(B0, 0, 0); PG8_LDB(B1, 0, 1); PG8_SCHED; PG8_LDA(At, 0, 0); PG8_STAGE(PG8_SA(1, 1), a1 + hstep, voffA);
            PG8_WAIT_V(8); PG8_WAIT_L(0); PG8_BAR; PG8_MMA(0, 0, At, B0); PG8_MMA(0, 1, At, B1); PG8_BAR; PG8_SCHED;
            PG8_LDA(At, 0, 1); PG8_STAGE(PG8_SB(0, 0), b2, voffB); PG8_STAGE(PG8_SB(0, 1), b2 + hstep, voffB); PG8_STAGE(PG8_SA(0, 0), a2, voffA);
            PG8_WAIT_V(8); PG8_WAIT_L(0); PG8_BAR; PG8_MMA(1, 0, At, B0); PG8_MMA(1, 1, At, B1); PG8_BAR; PG8_SCHED;
            PG8_LDB(B0, 1, 0); PG8_LDB(B1, 1, 1); PG8_SCHED; PG8_LDA(At, 1, 0); PG8_STAGE(PG8_SA(0, 1), a2 + hstep, voffA);
            PG8_WAIT_V(8); PG8_WAIT_L(0); PG8_BAR; PG8_MMA(0, 0, At, B0); PG8_MMA(0, 1, At, B1); PG8_BAR; PG8_SCHED;
            PG8_LDA(At, 1, 1); PG8_STAGE(PG8_SB(1, 0), b3, voffB); PG8_STAGE(PG8_SB(1, 1), b3 + hstep, voffB); PG8_STAGE(PG8_SA(1, 0), a3, voffA);
            PG8_WAIT_V(8); PG8_WAIT_L(0); PG8_BAR; PG8_MMA(1, 0, At, B0); PG8_MMA(1, 1, At, B1); PG8_BAR; PG8_SCHED;
            } else {
            PG8_LDB(B0, 0, 0); PG8_SCHED; PG8_LDA(At, 0, 0); PG8_STAGE(PG8_SA(1, 1), a1 + hstep, voffA);
            PG8_WAIT_L(8); PG8_BAR; PG8_WAIT_L(0); PG8_MMA(0, 0, At, B0); PG8_BAR; PG8_SCHED;
            PG8_LDB(B1, 0, 1); PG8_STAGE(PG8_SB(0, 0), b2, voffB);
            PG8_BAR; PG8_WAIT_L(0); PG8_MMA(0, 1, At, B1); PG8_BAR;
            PG8_LDA(At, 0, 1); PG8_STAGE(PG8_SA(0, 0), a2, voffA);
            PG8_BAR; PG8_WAIT_L(0); PG8_MMA(1, 0, At, B0); PG8_BAR; PG8_SCHED;
            PG8_STAGE(PG8_SB(0, 1), b2 + hstep, voffB);
            PG8_WAIT_V(6); PG8_BAR; PG8_MMA(1, 1, At, B1); PG8_BAR;
            PG8_LDB(B0, 1, 0); PG8_SCHED; PG8_LDA(At, 1, 0); PG8_STAGE(PG8_SA(0, 1), a2 + hstep, voffA);
            PG8_WAIT_L(8); PG8_BAR; PG8_WAIT_L(0); PG8_MMA(0, 0, At, B0); PG8_BAR; PG8_SCHED;
            PG8_LDB(B1, 1, 1); PG8_STAGE(PG8_SB(1, 0), b3, voffB);
            PG8_BAR; PG8_WAIT_L(0); PG8_MMA(0, 1, At, B1); PG8_BAR;
            PG8_LDA(At, 1, 1); PG8_STAGE(PG8_SA(1, 0), a3, voffA);
            PG8_BAR; PG8_WAIT_L(0); PG8_MMA(1, 0, At, B0); PG8_BAR; PG8_SCHED;
            PG8_STAGE(PG8_SB(1, 1), b3 + hstep, voffB);
            PG8_WAIT_V(6); PG8_BAR; PG8_MMA(1, 1, At, B1); PG8_BAR;
            }
        }
        if constexpr (ALIGN_EPI) { if (wr == 0) PG8_BAR; }
        if constexpr (!Epi::AFTER_DRAIN) { E(acc, cur, wr, wc, fr, fq); S.done(cur); }
        if (!has_next) break;
#pragma unroll
        for (int a = 0; a < 2; ++a)
#pragma unroll
            for (int b = 0; b < 2; ++b)
#pragma unroll
                for (int m = 0; m < 4; ++m)
#pragma unroll
                    for (int n = 0; n < 2; ++n) acc[a][b][m][n] = (f32x4){0.f, 0.f, 0.f, 0.f};
        cur = nxt; cA = nA; cB = nB; ++ui;
        if constexpr (ALIGN_EPI) { if (wr == 1) PG8_BAR; }
    }
    PG8_WAIT_V(0);
    if constexpr (!ALIGN_EPI) { if (wr == 0) PG8_BAR; }
    PG8_BAR;
    if constexpr (Epi::AFTER_DRAIN) { E.fused(acc, cur, wr, wc, fr, fq, lds, wid, lane); S.done(cur); }
#undef PG8_SA
#undef PG8_SB
#undef PG8_STAGE
#undef PG8_LDA
#undef PG8_LDB
#undef PG8_MMA
#undef PG8_WAIT_V
#undef PG8_WAIT_L
#undef PG8_BAR
#undef PG8_SCHED
}
}
#include <hip/hip_bf16.h>
#include <cmath>
namespace attn_body {
using bf16=__hip_bfloat16;
using bf16x8=__attribute__((ext_vector_type(8)))short;
using s16x4=__attribute__((ext_vector_type(4)))short;
using f32x16=__attribute__((ext_vector_type(16)))float;
using u32x4=__attribute__((ext_vector_type(4)))unsigned;
constexpr int BATCH=4,NHEAD=8,SEQ=4096,D=64,DM=NHEAD*D;
constexpr int NW=8,QBLK=32,QB=QBLK*NW,KVBLK=64,NQB=SEQ/QB;
constexpr int ATTN_PITCH=DM, ATTN_UNIT_ROWS=QB;
__device__ __forceinline__ int crow(int r,int hi){return (r&3)+8*(r>>2)+4*hi;}
#define SBAR() __builtin_amdgcn_sched_barrier(0)
__device__ __forceinline__ void cmask(f32x16&p0,f32x16&p1,int jb,int qrel,int hi){
  const float NEG=-INFINITY; int kb=64*jb+4*hi;
  #pragma unroll
  for(int r=0;r<16;++r){int kv=kb+(r&3)+8*(r>>2); if(kv>qrel)p0[r]=NEG; if(kv+32>qrel)p1[r]=NEG;}
}

constexpr int NSLOT=3, SLOTB=8192;
constexpr int LDS_K=0, LDS_V=NSLOT*SLOTB, LDS_WS=2*NSLOT*SLOTB, LDS_OST=LDS_WS+NW*64*4, LDS_KM=LDS_OST+NW*4096, LDS_BYTES=LDS_KM+4096;
constexpr float C2=0.125f*1.4426950408889634f;
__device__ __forceinline__ void glds16(const void*gsrc,unsigned lds_dst){unsigned keep;
  asm volatile("s_mov_b32 %0, m0\n\ts_mov_b32 m0, %2\n\ts_nop 0\n\tglobal_load_lds_dwordx4 %1, off\n\ts_mov_b32 m0, %0":"=&s"(keep):"v"(gsrc),"s"(lds_dst):"memory");}
__device__ __forceinline__ float max3f(float a,float b,float c){float r;asm("v_max3_f32 %0, %1, %2, %3":"=v"(r):"v"(a),"v"(b),"v"(c));return r;}
__device__ __forceinline__ float max2f(float a,float b){float r;asm("v_max_f32_e32 %0, %1, %2":"=v"(r):"v"(a),"v"(b));return r;}
__device__ __forceinline__ float fadd_s(float a,float b){float r;asm("v_add_f32_e32 %0, %1, %2":"=v"(r):"v"(a),"v"(b));return r;}
__device__ __forceinline__ float fsub_s(float a,float b){float r;asm("v_sub_f32_e32 %0, %1, %2":"=v"(r):"v"(a),"v"(b));return r;}
typedef float f32x2_t __attribute__((ext_vector_type(2))); typedef __bf16 bf16x2_t __attribute__((ext_vector_type(2)));
__device__ __forceinline__ unsigned cvtpk_s(float lo,float hi){f32x2_t v={lo,hi};bf16x2_t b=__builtin_convertvector(v,bf16x2_t);return __builtin_bit_cast(unsigned,b);}
#define WAIT_BAR(N) asm volatile("s_waitcnt vmcnt(" #N ") lgkmcnt(0)\n\ts_barrier":::"memory")

__device__ __forceinline__ void qkt(f32x16&p0,f32x16&p1,const char*Kslot,const bf16x8*qr,const f32x16&negm,int r32,int hi){
  const char*kb=Kslot+hi*1024+r32*16;
  #pragma unroll
  for(int d0=0;d0<4;++d0){
    const bf16x8 b0=*reinterpret_cast<const bf16x8*>(kb+d0*2048);
    const bf16x8 b1=*reinterpret_cast<const bf16x8*>(kb+d0*2048+512);
    if(d0==0){p0=__builtin_amdgcn_mfma_f32_32x32x16_bf16(b0,qr[0],negm,0,0,0);p1=__builtin_amdgcn_mfma_f32_32x32x16_bf16(b1,qr[0],negm,0,0,0);}
    else{p0=__builtin_amdgcn_mfma_f32_32x32x16_bf16(b0,qr[d0],p0,0,0,0);p1=__builtin_amdgcn_mfma_f32_32x32x16_bf16(b1,qr[d0],p1,0,0,0);}}
}
typedef __attribute__((address_space(3))) const char* lds_cptr;
typedef short v4i16_t __attribute__((ext_vector_type(4)));
__device__ __forceinline__ void kload8(bf16x8*kf,lds_cptr kp){
  kf[0]=*(const __attribute__((address_space(3))) bf16x8*)(kp);      kf[1]=*(const __attribute__((address_space(3))) bf16x8*)(kp+512);
  kf[2]=*(const __attribute__((address_space(3))) bf16x8*)(kp+2048); kf[3]=*(const __attribute__((address_space(3))) bf16x8*)(kp+2560);
  kf[4]=*(const __attribute__((address_space(3))) bf16x8*)(kp+4096); kf[5]=*(const __attribute__((address_space(3))) bf16x8*)(kp+4608);
  kf[6]=*(const __attribute__((address_space(3))) bf16x8*)(kp+6144); kf[7]=*(const __attribute__((address_space(3))) bf16x8*)(kp+6656);
}
__device__ __forceinline__ void kload2(bf16x8*kf,lds_cptr kp,int j){ kf[2*j]=*(const __attribute__((address_space(3))) bf16x8*)(kp+j*2048); kf[2*j+1]=*(const __attribute__((address_space(3))) bf16x8*)(kp+j*2048+512); }
__device__ __forceinline__ s16x4 vtr(lds_cptr p){ return __builtin_bit_cast(s16x4,__builtin_amdgcn_ds_read_tr16_b64_v4i16((__attribute__((address_space(3))) v4i16_t*)p)); }
__device__ __forceinline__ float rowmax(const f32x16&p0,const f32x16&p1){
  float a=max3f(p0[0],p0[1],p1[0]),b=max3f(p0[2],p0[3],p1[1]);a=max3f(a,p1[2],p1[3]);
  #pragma unroll
  for(int r=4;r<16;r+=4){a=max3f(a,p0[r],p0[r+1]);b=max3f(b,p0[r+2],p0[r+3]);a=max3f(a,p1[r],p1[r+1]);b=max3f(b,p1[r+2],p1[r+3]);}
  const float m=max2f(a,b);
  auto rr=__builtin_amdgcn_permlane32_swap(__float_as_uint(m),__float_as_uint(m),false,false);
  return max2f(__uint_as_float(rr[0]),__uint_as_float(rr[1]));
}
__device__ __forceinline__ void pv(f32x16*o,int vb,bf16x8 pa0,bf16x8 pa1,bf16x8 pa2,bf16x8 pa3){
  #pragma unroll
  for(int d0=0;d0<2;++d0){s16x4 lo[4],hi[4];
    #pragma unroll
    for(int ks=0;ks<4;++ks){
      asm volatile("ds_read_b64_tr_b16 %0,%1 offset:%c2":"=&v"(lo[ks]):"v"(vb),"i"(d0*4096+ks*1024):"memory");
      asm volatile("ds_read_b64_tr_b16 %0,%1 offset:%c2":"=&v"(hi[ks]):"v"(vb),"i"(d0*4096+ks*1024+512):"memory");}
    asm volatile("s_waitcnt lgkmcnt(0)":::"memory");SBAR();
    #define PK(k) (bf16x8){lo[k][0],lo[k][1],lo[k][2],lo[k][3],hi[k][0],hi[k][1],hi[k][2],hi[k][3]}
    o[d0]=__builtin_amdgcn_mfma_f32_32x32x16_bf16(pa0,PK(0),o[d0],0,0,0);
    o[d0]=__builtin_amdgcn_mfma_f32_32x32x16_bf16(pa1,PK(1),o[d0],0,0,0);
    o[d0]=__builtin_amdgcn_mfma_f32_32x32x16_bf16(pa2,PK(2),o[d0],0,0,0);
    o[d0]=__builtin_amdgcn_mfma_f32_32x32x16_bf16(pa3,PK(3),o[d0],0,0,0);
    #undef PK
  }
}

#ifndef ATTN_STORE16
#define ATTN_STORE16(p,v) (*(u32x4*)(p)=(v))
#endif
template<int THRL> __device__ __forceinline__ void attn_unit(int b,int h,int qb,const bf16*Q,const bf16*__restrict__ K,const bf16*__restrict__ V,bf16*O,const float*__restrict__ KMP,char*shm){
  int tid_=threadIdx.x; asm volatile("":"+v"(tid_)); const int tid=tid_,lane=tid&63,r32=lane&31,hi=lane>>5; const int wid=__builtin_amdgcn_readfirstlane(tid>>6);
  const long rowbase=(long)b*SEQ; const int q0=qb*QB;
  const bf16*Qw=Q+(rowbase+q0+wid*QBLK)*DM+h*D;
  const bf16*Kh=K+rowbase*DM+h*D,*Vh=V+rowbase*DM+h*D;
  unsigned selbits=(1u<<(qb+1))-1u;
  if(qb>3){
    float*kms=(float*)(shm+LDS_KM);
    for(int i=tid;i<qb*64;i+=512) kms[i]=KMP[((long)(b*16+(i>>6)))*DM+h*D+(i&63)];
    asm volatile("s_waitcnt vmcnt(0) lgkmcnt(0)\n\ts_barrier":::"memory");
    float qf[32];
    #pragma unroll
    for(int d0=0;d0<4;++d0){ const bf16x8 qv=*reinterpret_cast<const bf16x8*>(&Qw[(long)r32*DM+d0*16+hi*8]);
      #pragma unroll
      for(int e=0;e<8;++e) qf[d0*8+e]=__uint_as_float(((unsigned)(unsigned short)qv[e])<<16); }
    float v1=-INFINITY,v2=-INFINITY,v3=-INFINITY; int i1=0,i2=0,i3=0;
    for(int j=0;j<qb;++j){ float acc=0.f; const float*km=kms+j*64+hi*8;
      #pragma unroll
      for(int d0=0;d0<4;++d0){
        #pragma unroll
        for(int e=0;e<8;++e) acc+=qf[d0*8+e]*km[d0*16+e]; }
      acc+=__shfl_xor(acc,32);
      if(acc>v1){v3=v2;i3=i2;v2=v1;i2=i1;v1=acc;i1=j;} else if(acc>v2){v3=v2;i3=i2;v2=acc;i2=j;} else if(acc>v3){v3=acc;i3=j;} }
    selbits=(1u<<qb)|(1u<<i1)|(1u<<i2)|(1u<<i3);
    asm volatile("s_waitcnt lgkmcnt(0)\n\ts_barrier":::"memory");
  }
  #define MOFF(tt) ((((selbits)>>((tt)>>2))&1u)?0.f:-1000.f)
  const unsigned lds0=(unsigned)(uintptr_t)shm;
  float*wsf=(float*)(shm+LDS_WS)+wid*64;
  const bf16*ksrc=Kh+(long)lane*DM+wid*8;
  const bf16*vsrc=Vh+(long)(16*(wid&3)+(lane>>2))*DM+(wid>>2)*32+(lane&3)*8;
  const unsigned kdst=lds0+LDS_K+wid*1024, vdst=lds0+LDS_V+wid*1024;
  #define DMA_K(t,slot) glds16(ksrc+(long)(t)*KVBLK*DM,(unsigned)__builtin_amdgcn_readfirstlane(kdst+(slot)))
  #define DMA_V(t,slot) glds16(vsrc+(long)(t)*KVBLK*DM,(unsigned)__builtin_amdgcn_readfirstlane(vdst+(slot)))
  const int vb0=(int)(lds0+LDS_V)+((lane>>4)&1)*32+(lane&3)*8+(4*hi+((lane&15)>>2))*64;
  const char*Kbase=shm+LDS_K; bf16x8 kf[8];
  const lds_cptr shm3=(lds_cptr)shm; const lds_cptr kp0=shm3+LDS_K+hi*1024+r32*16; const lds_cptr vp0=shm3+LDS_V+((lane>>4)&1)*32+(lane&3)*8+(4*hi+((lane&15)>>2))*64;
  const int NT=(q0+QB)/KVBLK;
  DMA_K(0,0);DMA_V(0,0);DMA_K(1,SLOTB);
  bf16x8 qr[4];
  #pragma unroll
  for(int d0=0;d0<4;++d0)qr[d0]=*reinterpret_cast<const bf16x8*>(&Qw[(long)r32*DM+d0*16+hi*8]);
  float mhat=0.f,l_reg=0.f;f32x16 o[2];o[0]=f32x16{};o[1]=f32x16{};f32x16 negm; { const float nm0=MOFF(0); _Pragma("unroll") for(int r=0;r<16;++r)negm[r]=nm0; } asm volatile("":"+v"(negm));
  const int qrel=wid*QBLK+r32;
  #define CMASK(P0,P1,t) do{int jb_=(t)-(NT-4); if(jb_>=0)cmask(P0,P1,jb_,qrel,hi);}while(0)
  bool resc=false;
  #define START(P0,P1) do{ const float rm=rowmax(P0,P1); resc=false; \
    { const float dl=rm; mhat=fadd_s(mhat,dl); \
      _Pragma("unroll") for(int r=0;r<16;++r){P0[r]=fsub_s(P0[r],dl);P1[r]=fsub_s(P1[r],dl);} \
      { const float nm_=MOFF(1)-mhat; _Pragma("unroll") for(int r=0;r<16;++r)negm[r]=nm_; } asm volatile("":"+v"(negm)); } \
    _Pragma("unroll") for(int r=0;r<16;++r)P0[r]=__builtin_amdgcn_exp2f(P0[r]); }while(0)
  #define RESC() do{ if(resc){ asm volatile("s_waitcnt lgkmcnt(0)":::"memory"); \
      _Pragma("unroll") for(int d_=0;d_<2;++d_) _Pragma("unroll") for(int r=0;r<16;++r)o[d_][r]*=wsf[crow(r,hi)]; } }while(0)
  f32x16 pA0,pA1,pB0,pB1;
  int sl_prev=0,sl_cur=0,sl_next=SLOTB;
  #define ROT() do{sl_prev=sl_cur;sl_cur=sl_next;sl_next=(sl_next==(NSLOT-1)*SLOTB)?0:sl_next+SLOTB;}while(0)
  DMA_K(2,2*SLOTB);
  WAIT_BAR(3);
  qkt(pA0,pA1,Kbase,qr,negm,r32,hi);asm volatile("s_nop 15\n\ts_nop 7":"+v"(pA0),"+v"(pA1));CMASK(pA0,pA1,0);
  START(pA0,pA1);
  _Pragma("unroll") for(int r=0;r<16;++r)pA1[r]=__builtin_amdgcn_exp2f(pA1[r]);
  WAIT_BAR(0);
  DMA_K(3,0);DMA_V(1,SLOTB);
  ROT();
  kload8(kf,kp0+sl_cur);
  WAIT_BAR(2);
  s16x4 vlo[8],vhi[8]; u32x4 pw0,pw1,pw2,pw3;
  #define PKW(P,B) cvtpk_s(P[B],P[B+1])
  #define PAF(k) __builtin_bit_cast(bf16x8,pw##k)
  #define VFR(i) (bf16x8){vlo[i][0],vlo[i][1],vlo[i][2],vlo[i][3],vhi[i][0],vhi[i][1],vhi[i][2],vhi[i][3]}
  #define PIN(x) asm volatile("":"+v"(x))
  #define MX3(a,b,c) __builtin_fmaxf(__builtin_fmaxf((a),(b)),(c))
  #define GAPA(MF,A0,A1,A2,A3,W0,W1,PW) do{ MF; sacc+=A0; sacc+=A1; sacc+=A2; sacc+=A3; PIN(sacc); W0; W1; PIN(PW); SBAR(); }while(0)
  #define EX(v) __builtin_amdgcn_exp2f(v)
  #define GAPB(MF,X,B) do{ MF; X[B]=EX(X[B]); X[B+1]=EX(X[B+1]); X[B+2]=EX(X[B+2]); X[B+3]=EX(X[B+3]); PIN(X); SBAR(); }while(0)
  #define VRD(i) do{ vlo[i]=vtr(vp_+(((i)>>2)*4096+((i)&3)*1024)); vhi[i]=vtr(vp_+(((i)>>2)*4096+((i)&3)*1024+512)); }while(0)
  #define KRD(G,j) do{ if(G){ kload2(kf,kp0+sl_next,j); SBAR(); } }while(0)
  #define STEP(C0,C1,P0,P1,t,GK,GV,GL) do{ SBAR(); \
    const lds_cptr vp_=vp0+sl_prev; \
    VRD(0); SBAR(); float sacc=(P0[0]+P0[1]); \
    GAPA(C0=__builtin_amdgcn_mfma_f32_32x32x16_bf16(kf[0],qr[0],negm,0,0,0), P0[2],P0[3],P0[4],P0[5],     pw0[0]=PKW(P0,0), pw0[1]=PKW(P0,2), pw0); \
    VRD(4); SBAR(); GAPA(C1=__builtin_amdgcn_mfma_f32_32x32x16_bf16(kf[1],qr[0],negm,0,0,0), P0[6],P0[7],P0[8],P0[9],     pw0[2]=PKW(P0,4), pw0[3]=PKW(P0,6), pw0); \
    VRD(1); SBAR(); GAPA(C0=__builtin_amdgcn_mfma_f32_32x32x16_bf16(kf[2],qr[1],C0,0,0,0),   P0[10],P0[11],P0[12],P0[13], pw1[0]=PKW(P0,8), pw1[1]=PKW(P0,10), pw1); \
    VRD(5); SBAR(); GAPA(C1=__builtin_amdgcn_mfma_f32_32x32x16_bf16(kf[3],qr[1],C1,0,0,0),   P0[14],P0[15],P1[0],P1[1],   pw1[2]=PKW(P0,12),pw1[3]=PKW(P0,14), pw1); \
    VRD(2); SBAR(); GAPA(C0=__builtin_amdgcn_mfma_f32_32x32x16_bf16(kf[4],qr[2],C0,0,0,0),   P1[2],P1[3],P1[4],P1[5],     pw2[0]=PKW(P1,0), pw2[1]=PKW(P1,2), pw2); \
    VRD(6); SBAR(); GAPA(C1=__builtin_amdgcn_mfma_f32_32x32x16_bf16(kf[5],qr[2],C1,0,0,0),   P1[6],P1[7],P1[8],P1[9],     pw2[2]=PKW(P1,4), pw2[3]=PKW(P1,6), pw2); \
    VRD(3); SBAR(); GAPA(C0=__builtin_amdgcn_mfma_f32_32x32x16_bf16(kf[6],qr[3],C0,0,0,0),   P1[10],P1[11],P1[12],P1[13], pw3[0]=PKW(P1,8), pw3[1]=PKW(P1,10), pw3); \
    VRD(7); SBAR(); GAPA(C1=__builtin_amdgcn_mfma_f32_32x32x16_bf16(kf[7],qr[3],C1,0,0,0),   P1[14],P1[15],0.f,0.f,       pw3[2]=PKW(P1,12),pw3[3]=PKW(P1,14), pw3); \
    l_reg+=sacc; \
    if(GK){DMA_K((t)+3,sl_cur);} if(GV){DMA_V((t)+1,sl_next);} \
    CMASK(C0,C1,t); \
    { float a=MX3(C0[0],C0[1],C1[0]),b=MX3(C0[2],C0[3],C1[1]); a=MX3(a,C1[2],C1[3]); \
      _Pragma("unroll") for(int r=4;r<16;r+=4){a=MX3(a,C0[r],C0[r+1]);b=MX3(b,C0[r+2],C0[r+3]);a=MX3(a,C1[r],C1[r+1]);b=MX3(b,C1[r+2],C1[r+3]);} \
      float rm=__builtin_fmaxf(a,b); { auto rr=__builtin_amdgcn_permlane32_swap(__float_as_uint(rm),__float_as_uint(rm),false,false); rm=__builtin_fmaxf(__uint_as_float(rr[0]),__uint_as_float(rr[1])); } \
      resc=false; \
      if(__builtin_expect(__any(rm>(float)THRL),0)){ const float dl=__builtin_fmaxf(rm,0.f); mhat+=dl; \
        _Pragma("unroll") for(int r=0;r<16;++r){C0[r]-=dl;C1[r]-=dl;} \
        const float f=__builtin_amdgcn_exp2f(-dl); l_reg*=f; if(hi==0)wsf[r32]=f; resc=true; } \
      { const float nm_=MOFF((t)+1)-mhat; _Pragma("unroll") for(int r=0;r<16;++r)negm[r]=nm_; asm volatile("":"+v"(negm)); } } \
    SBAR(); \
    GAPB(o[0]=__builtin_amdgcn_mfma_f32_32x32x16_bf16(PAF(0),VFR(0),o[0],0,0,0), C0,0); \
    GAPB(o[1]=__builtin_amdgcn_mfma_f32_32x32x16_bf16(PAF(0),VFR(4),o[1],0,0,0), C0,4); \
    KRD(GL,0); GAPB(o[0]=__builtin_amdgcn_mfma_f32_32x32x16_bf16(PAF(1),VFR(1),o[0],0,0,0), C0,8); \
    KRD(GL,1); GAPB(o[1]=__builtin_amdgcn_mfma_f32_32x32x16_bf16(PAF(1),VFR(5),o[1],0,0,0), C0,12); \
    KRD(GL,2); GAPB(o[0]=__builtin_amdgcn_mfma_f32_32x32x16_bf16(PAF(2),VFR(2),o[0],0,0,0), C1,0); \
    KRD(GL,3); GAPB(o[1]=__builtin_amdgcn_mfma_f32_32x32x16_bf16(PAF(2),VFR(6),o[1],0,0,0), C1,4); \
    GAPB(o[0]=__builtin_amdgcn_mfma_f32_32x32x16_bf16(PAF(3),VFR(3),o[0],0,0,0), C1,8); \
    GAPB(o[1]=__builtin_amdgcn_mfma_f32_32x32x16_bf16(PAF(3),VFR(7),o[1],0,0,0), C1,12); \
    }while(0)
  int t=1;
  #undef CMASK
  #define CMASK(P0,P1,t) do{}while(0)
  for(;t+5<NT;t+=2){
    STEP(pB0,pB1,pA0,pA1,t,true,true,true);     WAIT_BAR(2); RESC(); ROT();
    STEP(pA0,pA1,pB0,pB1,t+1,true,true,true);   WAIT_BAR(2); RESC(); ROT();
  }
  #undef CMASK
  #define CMASK(P0,P1,t) do{int jb_=(t)-(NT-4); if(jb_>=0)cmask(P0,P1,jb_,qrel,hi);}while(0)
  #define ENDW(tt) do{ if((tt)+3<NT){WAIT_BAR(2);} else if((tt)+2<NT){WAIT_BAR(1);} else {WAIT_BAR(0);} }while(0)
  for(;t+1<NT;t+=2){
    STEP(pB0,pB1,pA0,pA1,t,(t+3<NT),(t+1<NT),(t+1<NT));       ENDW(t);   RESC(); ROT();
    STEP(pA0,pA1,pB0,pB1,t+1,(t+4<NT),(t+2<NT),(t+2<NT));     ENDW(t+1); RESC(); ROT();
  }
  STEP(pB0,pB1,pA0,pA1,NT-1,false,false,false); RESC();
  { float sacc=pB0[0]+pB0[1]; _Pragma("unroll") for(int r=2;r<16;++r)sacc+=pB0[r]; _Pragma("unroll") for(int r=0;r<16;++r)sacc+=pB1[r]; l_reg+=sacc;
    pw0=(u32x4){PKW(pB0,0),PKW(pB0,2),PKW(pB0,4),PKW(pB0,6)};pw1=(u32x4){PKW(pB0,8),PKW(pB0,10),PKW(pB0,12),PKW(pB0,14)};pw2=(u32x4){PKW(pB1,0),PKW(pB1,2),PKW(pB1,4),PKW(pB1,6)};pw3=(u32x4){PKW(pB1,8),PKW(pB1,10),PKW(pB1,12),PKW(pB1,14)};
    SBAR(); pv(o,vb0+sl_cur,PAF(0),PAF(1),PAF(2),PAF(3)); }
  #undef PKW
  #undef PAF
  #undef VFR
  #undef PIN
  #undef MX3
  #undef GAPA
  #undef GAPB
  #undef EX
  #undef VRD
  #undef KRD
  #undef STEP
  #undef ENDW
  {auto rr=__builtin_amdgcn_permlane32_swap(__float_as_uint(l_reg),__float_as_uint(l_reg),false,false);l_reg=__uint_as_float(rr[0])+__uint_as_float(rr[1]);}
  if(hi==0)wsf[32+r32]=l_reg;asm volatile("s_waitcnt lgkmcnt(0)":::"memory");
  float rli[16];
  #pragma unroll
  for(int r=0;r<16;++r)rli[r]=__builtin_amdgcn_rcpf(wsf[32+crow(r,hi)]);
  bf16*Ow=O+(rowbase+q0+wid*QBLK)*DM+h*D;
  { bf16*stg=(bf16*)(shm+LDS_OST)+wid*2048;
    #pragma unroll
    for(int r=0;r<16;++r){const int orow=crow(r,hi);
      #pragma unroll
      for(int d0=0;d0<2;++d0)stg[orow*64+d0*32+r32]=__float2bfloat16(o[d0][r]*rli[r]);}
    asm volatile("s_waitcnt lgkmcnt(0)":::"memory");
    #pragma unroll
    for(int i=0;i<4;++i){const int row=i*8+(lane>>3),ch=lane&7; const u32x4 v=*(const u32x4*)(stg+row*64+ch*8); ATTN_STORE16(Ow+(long)row*DM+ch*8,v);} }
  asm volatile("s_waitcnt lgkmcnt(0)\n\ts_barrier":::"memory");
  #undef DMA_K
  #undef DMA_V
  #undef CMASK
  #undef START
  #undef RESC
  #undef ROT
  #undef MOFF
}
constexpr int ATTN_LDS_BYTES=LDS_BYTES;
struct AttnTensors { const bf16* Q; const bf16* K; const bf16* V; bf16* O; const float* KM; };
struct AttnUnit { int bh; int qb; };
struct StaticOrder {
  int vcu;
  __device__ __forceinline__ explicit StaticOrder(int grid,int block):vcu((block%8)*(grid/8)+block/8){}
  __device__ __forceinline__ bool next(int i,AttnUnit&u)const{ if(i>=2)return false; const int s=vcu&7; u.bh=vcu>>3; u.qb=(i==0)?15-s:s; return true; }
  __device__ __forceinline__ void a_ready(const AttnUnit&)const{}
  __device__ __forceinline__ void done(const AttnUnit&)const{}
};
template<class Sched,int THRL=8> __device__ __forceinline__ void attn_phase(char*lds,const AttnTensors&T,const Sched&S){
  AttnUnit u;
  for(int i=0;S.next(i,u);++i){ S.a_ready(u); attn_unit<THRL>(u.bh/NHEAD,u.bh%NHEAD,u.qb,T.Q,T.K,T.V,T.O,T.KM,lds); S.done(u); }
}
#undef SBAR
#undef WAIT_BAR
}
#define GAS __attribute__((address_space(1)))
#define LAS __attribute__((address_space(3)))
typedef unsigned short bf16;
typedef unsigned v4u __attribute__((ext_vector_type(4)));
typedef float f32x4 __attribute__((ext_vector_type(4)));
typedef short bf16x8 __attribute__((ext_vector_type(8)));
typedef GAS unsigned gu32;
typedef GAS unsigned long long gu64;
#define RLX_AGENT __ATOMIC_RELAXED, __HIP_MEMORY_SCOPE_AGENT
#define LDS_WAIT() asm volatile("s_waitcnt lgkmcnt(0)" ::: "memory")
#define VM_WAIT() asm volatile("s_waitcnt vmcnt(0)" ::: "memory")
__device__ __forceinline__ unsigned long long rt() { return __builtin_amdgcn_s_memrealtime(); }
__device__ __forceinline__ unsigned f2bf(float f) { unsigned u = __builtin_bit_cast(unsigned, f); return (u + 0x7fffu + ((u >> 16) & 1u)) >> 16; }
__device__ __forceinline__ unsigned pk2(float lo, float hi) { return f2bf(lo) | (f2bf(hi) << 16); }

#define XB_TMO      128
#define XB_XCNT(j)  (256  + 64 * (j))
#define XB_XSUB(j)  (1280 + 64 * (j))
#define XB_XGEN(j)  (2304 + 64 * (j))
#define XB_TOP      3328
#define XB_TOPGEN   3392
#define XCD_BAR_WORDS 3456
#define XB_SPIN_CAP (1u << 18)

__device__ __forceinline__ unsigned xb_ld(unsigned* p)              { return __hip_atomic_load(p, __ATOMIC_RELAXED, __HIP_MEMORY_SCOPE_AGENT); }
__device__ __forceinline__ unsigned xb_add(unsigned* p, unsigned v) { return __hip_atomic_fetch_add(p, v, __ATOMIC_RELAXED, __HIP_MEMORY_SCOPE_AGENT); }
__device__ __forceinline__ unsigned xb_xcc_id() { return (unsigned)__builtin_amdgcn_s_getreg((3 << 11) | 20) & 0xFu; }
#define XB_SPIN(cond, bar) do { unsigned _sp = 0; while (cond) { __builtin_amdgcn_s_sleep(1); \
    if ((++_sp & 255u) == 0u) { if (xb_ld(&(bar)[XB_TMO])) break; if (_sp > XB_SPIN_CAP) { atomicAdd(&(bar)[XB_TMO], 1u); break; } } } } while (0)

struct XcdBarrier {
    unsigned* bar; unsigned x;
    volatile LAS unsigned* st;
};

__device__ __forceinline__ XcdBarrier xcd_barrier_post(unsigned* bar, volatile LAS unsigned* st) {
    XcdBarrier b; b.bar = bar; b.x = xb_xcc_id(); b.st = st;
    if (threadIdx.x == 0) (void)xb_add(&bar[XB_XCNT(b.x)], 1u);
    return b;
}
__device__ __forceinline__ void xcd_barrier_complete(unsigned* bar, unsigned x, unsigned& nloc, unsigned& nx) {
    const unsigned G = gridDim.x * gridDim.y * gridDim.z;
    unsigned sum, cnt, mine, sp = 0u;
    for (;;) {
        sum = 0u; cnt = 0u; mine = 0u;
#pragma unroll
        for (unsigned j = 0; j < 16; ++j) { const unsigned c = xb_ld(&bar[XB_XCNT(j)]); sum += c; cnt += (c > 0u) ? 1u : 0u; mine = (j == x) ? c : mine; }
        if (sum == G) break;
        __builtin_amdgcn_s_sleep(1);
        if ((++sp & 255u) == 0u) { if (xb_ld(&bar[XB_TMO])) break; if (sp > XB_SPIN_CAP) { atomicAdd(&bar[XB_TMO], 1u); break; } }
    }
    nloc = mine > 0u ? mine : 1u; nx = cnt > 0u ? cnt : 1u;
}

__device__ __forceinline__ void xcd_barrier(const XcdBarrier& b) {
    asm volatile("s_waitcnt vmcnt(0)" ::: "memory");
    __syncthreads();
    if (threadIdx.x == 0) {
        unsigned* bar = b.bar;
        __builtin_amdgcn_s_waitcnt(0);
        unsigned nloc = b.st[0], nx = b.st[1];
        if (nloc == 0u) { xcd_barrier_complete(bar, b.x, nloc, nx); b.st[0] = nloc; b.st[1] = nx; }
        const unsigned old = xb_add(&bar[XB_XSUB(b.x)], 1u);
        const unsigned gen = old / nloc;
        if (old + 1u == (gen + 1u) * nloc) {
            __builtin_amdgcn_fence(__ATOMIC_RELEASE, "agent");
            asm volatile("s_waitcnt vmcnt(0)" ::: "memory");
            const unsigned og = xb_add(&bar[XB_TOP], 1u);
            const unsigned tg = og / nx;
            if (og + 1u == (tg + 1u) * nx) xb_add(&bar[XB_TOPGEN], 1u);
            else XB_SPIN(xb_ld(&bar[XB_TOPGEN]) == tg, bar);
            __builtin_amdgcn_fence(__ATOMIC_ACQUIRE, "agent");
            xb_add(&bar[XB_XGEN(b.x)], 1u);
            asm volatile("s_waitcnt vmcnt(0)" ::: "memory");
        } else {
            XB_SPIN(xb_ld(&bar[XB_XGEN(b.x)]) == gen, bar);
            __builtin_amdgcn_fence(__ATOMIC_ACQUIRE, "agent");
            asm volatile("s_waitcnt vmcnt(0)" ::: "memory");
        }
    }
    __syncthreads();
}

constexpr int NWAVES = 8;
constexpr int M = 16384, MS = 32, MP = 16640;
constexpr int D = 1024, NIN = 4096, AW = 512, SW = 512, FF = 2816, SEQ = 4096, NBATCH = 4;
constexpr int NG = 32, NP = 64, NC = 16;
constexpr float RMS_EPS = 1e-6f;
constexpr int PAST = 8192, PAGE = 128, NPAGES = 64;
constexpr size_t OUT_Y = 0, OUT_YS = 16777216, OUT_KP = OUT_YS + 32768, OUT_VP = OUT_KP + 8388608, OUT_RP = OUT_VP + 8388608, OUT_IP = OUT_RP + 8192,
                 OUT_KS = OUT_IP + 8192, OUT_VS = OUT_KS + 16384, OUT_RS = OUT_VS + 16384, OUT_IS = OUT_RS + 65536, OUT_TOTAL = OUT_IS + 65536;
static_assert(OUT_TOTAL == 33767424, "output size");
enum { I_XP = 0, I_XS, I_CK, I_CV, I_SRE, I_SIM, I_PT, I_NMIX, I_WIN, I_WA, I_ARE, I_AIM, I_LDT, I_BRE, I_BIM, I_CRE, I_CIM, I_SD, I_WGLU, I_BGLU, I_WSP, I_WOUT, I_NFFN, I_WFI, I_WFO, I_NFIN, N_IN };
static_assert(N_IN == 26, "inputs");

constexpr size_t MiB = 1u << 20;
constexpr size_t WS_CTL = 0, CTL_ZERO_BYTES = 1 * MiB;
constexpr size_t WS_WIN = 2 * MiB, WS_WA = 10 * MiB, WS_WSP = 11 * MiB, WS_WGLU = 12 * MiB, WS_WOUT = 13 * MiB, WS_WFI = 15 * MiB, WS_WFO = 26 * MiB;
constexpr size_t WS_ROPE = 32 * MiB;
constexpr size_t WS_SSMC = 34 * MiB;
constexpr size_t SC_ABAR = 0, SC_AT = 16384, SC_BFRAG = 32768, SC_CFRAG = SC_BFRAG + 131072, SC_BBARF = SC_CFRAG + 131072, SC_END = SC_BBARF + 262144;
static_assert(SC_END <= 2 * MiB, "ssm constants");
constexpr size_t WS_KMS = 36 * MiB;
constexpr size_t WS_KMP = 38 * MiB;
constexpr size_t WS_SSE = 39 * MiB;
constexpr size_t WS_XN = 48 * MiB;
constexpr size_t WS_Q = 82 * MiB, WS_K = 100 * MiB, WS_V = 118 * MiB;
constexpr size_t WS_U = 136 * MiB;
constexpr size_t WS_SGA = 170 * MiB, WS_SGS = 204 * MiB;
constexpr size_t WS_Z = 238 * MiB, WS_Z2 = 256 * MiB;
constexpr size_t WS_T1 = 274 * MiB, WS_MG = 308 * MiB;
constexpr size_t WS_X1 = 342 * MiB;
constexpr size_t WS_HF = 408 * MiB;
constexpr size_t WS_H = 442 * MiB;
constexpr size_t WS_END = 536 * MiB;
static_assert(WS_H + (size_t)MP * FF * 2 <= WS_END && WS_X1 + (size_t)MP * D * 4 <= WS_HF && WS_XN + (size_t)MP * D * 2 <= WS_Q, "ws map");
constexpr int CW_TMO = 0, CW_CODE = 1, CW_BAR = 4096;

constexpr int RING_OFF = 0, RING_BYTES = 131072;
constexpr int LDSCTL_OFF = RING_BYTES, MISC_OFF = LDSCTL_OFF + 320;
constexpr int LDS_BYTES = 147456;
static_assert(MISC_OFF + 128 <= LDS_BYTES, "LDS map");

typedef float f32x2 __attribute__((ext_vector_type(2)));
typedef unsigned u32x2 __attribute__((ext_vector_type(2)));
typedef short s16x4 __attribute__((ext_vector_type(4)));

__device__ __forceinline__ float wave_sum(float v) {
#pragma unroll
    for (int o = 1; o < 64; o <<= 1) v += __shfl_xor(v, o);
    return v;
}
__device__ __forceinline__ float fsigmoid(float x) { return __builtin_amdgcn_rcpf(1.0f + __expf(-x)); }
__device__ __forceinline__ float gelu_tanh(float x) { const float u = 0.7978845608028654f * (x + 0.044715f * x * x * x); return x * fsigmoid(2.0f * u); }
__device__ __forceinline__ float bf2f(unsigned short b) { return __uint_as_float(((unsigned)b) << 16); }
__device__ __forceinline__ u32x2 pack4(f32x4 v) { u32x2 r; r.x = pk2(v[0], v[1]); r.y = pk2(v[2], v[3]); return r; }

struct Frame {
    LAS unsigned char* lds;
    volatile LAS unsigned* MISC;
    gu32* ctl;
    int tid, lane, wave, vcu, G;
    const void* const* in;
    float* out; unsigned char* ws;
};
#define INF(F, i) ((const float*)(F).in[i])

__device__ const double ROPE_INV[32] = {
    1.0, 0.7498942093324559, 0.5623413251903491, 0.4216965034285822, 0.31622776601683794, 0.23713737056616552, 0.1778279410038923, 0.1333521432163324,
    0.1, 0.07498942093324558, 0.05623413251903491, 0.04216965034285822, 0.03162277660168379, 0.023713737056616554, 0.01778279410038923, 0.01333521432163324,
    0.01, 0.007498942093324558, 0.005623413251903491, 0.004216965034285823, 0.0031622776601683794, 0.0023713737056616554, 0.0017782794100389228, 0.001333521432163324,
    0.001, 0.0007498942093324559, 0.0005623413251903491, 0.00042169650342858224, 0.00031622776601683794, 0.00023713737056616554, 0.00017782794100389227, 0.0001333521432163324};

struct EpiCtx { const float* xp; const float* xs; float* out; unsigned char* ws; const float* bglu; };

template <int SEC, bool SAMPLE> __device__ __forceinline__ void epi_inproj(const EpiCtx& c, int row, int c32, int fq, f32x4 v0, f32x4 v1) {
    if constexpr (SEC <= 1) {
        const int cq = c32 & 511, head = cq >> 6, half = (cq >> 5) & 1, i0 = 16 * half + 4 * fq;
        const int pidx = SAMPLE ? 4096 : (row & 4095);
        const f32x4* rp = (const f32x4*)(c.ws + WS_ROPE) + ((size_t)pidx * 32 + i0) / 2;
        const f32x4 cs01 = rp[0], cs23 = rp[1];
        const f32x4 cc = {cs01[0], cs01[2], cs23[0], cs23[2]}, ss = {cs01[1], cs01[3], cs23[1], cs23[3]};
        f32x4 o1 = v0 * cc - v1 * ss, o2 = v1 * cc + v0 * ss;
        const int col1 = head * 64 + i0, col2 = col1 + 32;
        if constexpr (SEC == 0) {
            constexpr float C2 = 0.125f * 1.4426950408889634f;
            o1 = o1 * C2; o2 = o2 * C2;
            bf16* q = (bf16*)(c.ws + WS_Q) + (size_t)row * AW;
            *(u32x2*)(q + col1) = pack4(o1); *(u32x2*)(q + col2) = pack4(o2);
        } else {
            bf16* k = (bf16*)(c.ws + WS_K) + (size_t)row * AW;
            *(u32x2*)(k + col1) = pack4(o1); *(u32x2*)(k + col2) = pack4(o2);
            float* nk = SAMPLE ? c.out + OUT_KS + (size_t)(row - M) * AW : c.out + OUT_KP + (size_t)row * AW;
            *(f32x4*)(nk + col1) = o1; *(f32x4*)(nk + col2) = o2;
        }
    } else if constexpr (SEC == 2) {
        const int col = (c32 & 511) + 4 * fq;
        bf16* v = (bf16*)(c.ws + WS_V) + (size_t)row * AW;
        *(u32x2*)(v + col) = pack4(v0); *(u32x2*)(v + col + 16) = pack4(v1);
        float* nv = SAMPLE ? c.out + OUT_VS + (size_t)(row - M) * AW : c.out + OUT_VP + (size_t)row * AW;
        *(f32x4*)(nv + col) = v0; *(f32x4*)(nv + col + 16) = v1;
    } else if constexpr (SEC == 3) {
        const int col = (c32 & 511) + 4 * fq;
        float* u = (float*)(c.ws + WS_U) + (size_t)row * SW;
        *(f32x4*)(u + col) = v0; *(f32x4*)(u + col + 16) = v1;
    } else {
        const int col = (c32 & 1023) + 4 * fq;
        bf16* g = (bf16*)(c.ws + (SEC == 4 ? WS_SGA : WS_SGS)) + (size_t)row * D;
        f32x4 s0, s1;
#pragma unroll
        for (int e = 0; e < 4; ++e) { s0[e] = fsigmoid(v0[e]); s1[e] = fsigmoid(v1[e]); }
        *(u32x2*)(g + col) = pack4(s0); *(u32x2*)(g + col + 16) = pack4(s1);
    }
}
template <bool SAMPLE> __device__ __forceinline__ void epi_inproj_dyn(const EpiCtx& c, int row, int c32, int fq, f32x4 v0, f32x4 v1) {
    const int sec = c32 >> 9;
    if (sec == 0) epi_inproj<0, SAMPLE>(c, row, c32, fq, v0, v1); else if (sec == 1) epi_inproj<1, SAMPLE>(c, row, c32, fq, v0, v1);
    else if (sec == 2) epi_inproj<2, SAMPLE>(c, row, c32, fq, v0, v1); else if (sec == 3) epi_inproj<3, SAMPLE>(c, row, c32, fq, v0, v1);
    else if (sec < 6) epi_inproj<4, SAMPLE>(c, row, c32, fq, v0, v1); else epi_inproj<5, SAMPLE>(c, row, c32, fq, v0, v1);
}
__device__ __forceinline__ f32x4 ld_bf4(const bf16* p) { const u32x2 w = *(const u32x2*)p; f32x4 r; r[0] = __uint_as_float(w.x << 16); r[1] = __uint_as_float(w.x & 0xffff0000u); r[2] = __uint_as_float(w.y << 16); r[3] = __uint_as_float(w.y & 0xffff0000u); return r; }
template <int KIND, bool SAMPLE> __device__ __forceinline__ void epi_elem(const EpiCtx& c, int row, int c32, int fq, f32x4 v0, f32x4 v1) {
    const int col = c32 + 4 * fq;
    if constexpr (KIND == 1) {
        const bf16* z = (const bf16*)(c.ws + WS_Z) + (size_t)row * SW + col; bf16* z2 = (bf16*)(c.ws + WS_Z2) + (size_t)row * SW + col;
        const f32x4 b0 = *(const f32x4*)(c.bglu + col), b1 = *(const f32x4*)(c.bglu + col + 16);
        const f32x4 za = ld_bf4(z), zb = ld_bf4(z + 16); f32x4 r0, r1;
#pragma unroll
        for (int e = 0; e < 4; ++e) { r0[e] = za[e] * fsigmoid(v0[e] + b0[e]); r1[e] = zb[e] * fsigmoid(v1[e] + b1[e]); }
        *(u32x2*)z2 = pack4(r0); *(u32x2*)(z2 + 16) = pack4(r1);
    } else if constexpr (KIND == 2) {
        const bf16* g = (const bf16*)(c.ws + WS_SGA) + (size_t)row * D + col; bf16* t = (bf16*)(c.ws + WS_T1) + (size_t)row * D + col;
        *(u32x2*)t = pack4(ld_bf4(g) * v0); *(u32x2*)(t + 16) = pack4(ld_bf4(g + 16) * v1);
    } else if constexpr (KIND == 3) {
        const bf16* g = (const bf16*)(c.ws + WS_SGS) + (size_t)row * D + col; const bf16* t = (const bf16*)(c.ws + WS_T1) + (size_t)row * D + col; bf16* mg = (bf16*)(c.ws + WS_MG) + (size_t)row * D + col;
        *(u32x2*)mg = pack4(ld_bf4(t) + ld_bf4(g) * v0); *(u32x2*)(mg + 16) = pack4(ld_bf4(t + 16) + ld_bf4(g + 16) * v1);
    } else if constexpr (KIND == 4) {
        const float* x = SAMPLE ? c.xs + (size_t)(row - M) * D + col : c.xp + (size_t)row * D + col; float* x1 = (float*)(c.ws + WS_X1) + (size_t)row * D + col;
        *(f32x4*)x1 = *(const f32x4*)x + v0; *(f32x4*)(x1 + 16) = *(const f32x4*)(x + 16) + v1;
    } else if constexpr (KIND == 5) {
        bf16* h = (bf16*)(c.ws + WS_H) + (size_t)row * FF + (c32 >> 1) + 4 * fq; f32x4 r;
#pragma unroll
        for (int e = 0; e < 4; ++e) r[e] = v0[e] * fsigmoid(v0[e]) * v1[e];
        *(u32x2*)h = pack4(r);
    } else {
        const float* x1 = (const float*)(c.ws + WS_X1) + (size_t)row * D + col; float* o = SAMPLE ? c.out + OUT_YS + (size_t)(row - M) * D + col : c.out + OUT_Y + (size_t)row * D + col;
        *(f32x4*)o = *(const f32x4*)x1 + v0; *(f32x4*)(o + 16) = *(const f32x4*)(x1 + 16) + v1;
    }
}
template <int KIND> struct EpiG {
    static constexpr bool PERM = false, AFTER_DRAIN = false;
    EpiCtx c;
    template <int SEC> __device__ __forceinline__ void run_inproj(const pg8::f32x4 (&acc)[2][2][4][2], const pg8::Unit& u, int wr, int wc, int fr, int fq) const {
#pragma unroll
        for (int ai = 0; ai < 2; ++ai)
#pragma unroll
            for (int m = 0; m < 4; ++m) { const int row = u.pm * 256 + ai * 128 + wr * 64 + m * 16 + fr;
#pragma unroll
                for (int bj = 0; bj < 2; ++bj) epi_inproj<SEC, false>(c, row, u.pn * 256 + bj * 128 + wc * 32, fq, acc[ai][bj][m][0], acc[ai][bj][m][1]); }
    }
    __device__ __forceinline__ void operator()(const pg8::f32x4 (&acc)[2][2][4][2], const pg8::Unit& u, int wr, int wc, int fr_, int fq_) const {
        int t_ = threadIdx.x; asm volatile("" : "+v"(t_)); const int fr = t_ & 15, fq = (t_ >> 4) & 3;
        if constexpr (KIND == 0) {
            const int sec = u.pn >> 1;
            if (sec == 0) run_inproj<0>(acc, u, wr, wc, fr, fq); else if (sec == 1) run_inproj<1>(acc, u, wr, wc, fr, fq); else if (sec == 2) run_inproj<2>(acc, u, wr, wc, fr, fq);
            else if (sec == 3) run_inproj<3>(acc, u, wr, wc, fr, fq); else if (sec < 6) run_inproj<4>(acc, u, wr, wc, fr, fq); else run_inproj<5>(acc, u, wr, wc, fr, fq);
        } else {
#pragma unroll
            for (int ai = 0; ai < 2; ++ai)
#pragma unroll
                for (int m = 0; m < 4; ++m) { const int row = u.pm * 256 + ai * 128 + wr * 64 + m * 16 + fr;
#pragma unroll
                    for (int bj = 0; bj < 2; ++bj) epi_elem<KIND, false>(c, row, u.pn * 256 + bj * 128 + wc * 32, fq, acc[ai][bj][m][0], acc[ai][bj][m][1]); }
        }
    }
};

template <int KIND> __device__ __forceinline__ void skinny32(Frame& F, const EpiCtx& c, const bf16* A, int lda, const bf16* Bt, int K, int N) {
    const int lane = F.lane, fr = lane & 15, fq = lane >> 4, nstrips = N / 32, kw = K / 8;
    LAS f32x4* red = (LAS f32x4*)(F.lds + RING_OFF);
    for (int st = F.vcu; st < nstrips; st += F.G) {
        f32x4 acc[2][2];
#pragma unroll
        for (int a = 0; a < 2; ++a)
#pragma unroll
            for (int b = 0; b < 2; ++b) acc[a][b] = (f32x4){0.f, 0.f, 0.f, 0.f};
        const bf16* ap = A + (size_t)fr * lda + F.wave * kw + 8 * fq;
        const bf16* bp = Bt + (size_t)(32 * st + fr) * K + F.wave * kw + 8 * fq;
        for (int kk = 0; kk < kw; kk += 32) {
            const bf16x8 a0 = *(const bf16x8*)(ap + kk), a1 = *(const bf16x8*)(ap + (size_t)16 * lda + kk);
            const bf16x8 b0 = *(const bf16x8*)(bp + kk), b1 = *(const bf16x8*)(bp + (size_t)16 * K + kk);
            acc[0][0] = __builtin_amdgcn_mfma_f32_16x16x32_bf16(b0, a0, acc[0][0], 0, 0, 0); acc[0][1] = __builtin_amdgcn_mfma_f32_16x16x32_bf16(b1, a0, acc[0][1], 0, 0, 0);
            acc[1][0] = __builtin_amdgcn_mfma_f32_16x16x32_bf16(b0, a1, acc[1][0], 0, 0, 0); acc[1][1] = __builtin_amdgcn_mfma_f32_16x16x32_bf16(b1, a1, acc[1][1], 0, 0, 0);
        }
#pragma unroll
        for (int a = 0; a < 2; ++a)
#pragma unroll
            for (int b = 0; b < 2; ++b) red[(F.wave * 4 + a * 2 + b) * 64 + lane] = acc[a][b];
        __syncthreads();
        if (F.wave < 2) {
            const int mb = F.wave; f32x4 v0 = (f32x4){0.f, 0.f, 0.f, 0.f}, v1 = v0;
#pragma unroll
            for (int w = 0; w < 8; ++w) { v0 += red[(w * 4 + mb * 2 + 0) * 64 + lane]; v1 += red[(w * 4 + mb * 2 + 1) * 64 + lane]; }
            const int row = M + 16 * mb + fr;
            if constexpr (KIND == 0) epi_inproj_dyn<true>(c, row, 32 * st, fq, v0, v1); else epi_elem<KIND, true>(c, row, 32 * st, fq, v0, v1);
        }
        __syncthreads();
    }
}

template <int PK> __device__ __forceinline__ int wperm(int n) {
    if constexpr (PK == 1) { if (n >= 1024) return n; const int sec = n >> 9, cq = n & 511, head = cq >> 6, hl = cq & 63, half = hl >> 5, s = (hl >> 4) & 1, jj = hl & 15; return sec * 512 + head * 64 + 16 * half + jj + 32 * s; }
    else if constexpr (PK == 2) { const int jb = n >> 5, s = (n >> 4) & 1, jj = n & 15; return 16 * jb + jj + FF * s; }
    else return n;
}
template <int PK> __device__ __forceinline__ void p0_transpose_item(const float* W, int K, int N, bf16* WT, LAS float* scr, int item, int lane) {
    const int nblk = N / 32, kb = item / nblk, nb = item % nblk, k0 = 64 * kb, n0 = 32 * nb;
    const int ncol = wperm<PK>(n0 + (lane & 31));
#pragma unroll 8
    for (int i = 0; i < 32; ++i) { const int kk = 2 * i + (lane >> 5); scr[kk * 33 + (lane & 31)] = W[(size_t)(k0 + kk) * N + ncol]; }
    LDS_WAIT(); asm volatile("" ::: "memory");
    const int c = lane & 7;
#pragma unroll
    for (int j = 0; j < 4; ++j) { const int n = (lane >> 3) + 8 * j; const LAS float* s = scr + (8 * c) * 33 + n;
        v4u o; o.x = pk2(s[0 * 33], s[1 * 33]); o.y = pk2(s[2 * 33], s[3 * 33]); o.z = pk2(s[4 * 33], s[5 * 33]); o.w = pk2(s[6 * 33], s[7 * 33]);
        *(GAS v4u*)(WT + (size_t)(n0 + n) * K + k0 + 8 * c) = o; }
    LDS_WAIT(); asm volatile("" ::: "memory");
}
__device__ __forceinline__ void rms_row_to_bf16(const float* xrow, const float* gain, bf16* orow, int lane) {
    const GAS f32x4* xr = (const GAS f32x4*)xrow + lane; const GAS f32x4* gr = (const GAS f32x4*)gain + lane;
    f32x4 v[4]; float s2 = 0.f;
#pragma unroll
    for (int j = 0; j < 4; ++j) { v[j] = xr[64 * j]; s2 += (v[j].x * v[j].x + v[j].y * v[j].y) + (v[j].z * v[j].z + v[j].w * v[j].w); }
    const float rstd = 1.0f / sqrtf(wave_sum(s2) * (1.f / D) + RMS_EPS);
    GAS u32x2* o8 = (GAS u32x2*)orow + lane;
#pragma unroll
    for (int j = 0; j < 4; ++j) { const f32x4 g = gr[64 * j]; o8[64 * j] = pack4(v[j] * rstd * g); }
}
__device__ __forceinline__ void rms_row_to_f32(const float* xrow, const float* gain, float* orow, int lane) {
    const GAS f32x4* xr = (const GAS f32x4*)xrow + lane; const GAS f32x4* gr = (const GAS f32x4*)gain + lane;
    f32x4 v[4]; float s2 = 0.f;
#pragma unroll
    for (int j = 0; j < 4; ++j) { v[j] = xr[64 * j]; s2 += (v[j].x * v[j].x + v[j].y * v[j].y) + (v[j].z * v[j].z + v[j].w * v[j].w); }
    const float rstd = 1.0f / sqrtf(wave_sum(s2) * (1.f / D) + RMS_EPS);
    GAS f32x4* o = (GAS f32x4*)orow + lane;
#pragma unroll
    for (int j = 0; j < 4; ++j) { const f32x4 g = gr[64 * j]; o[64 * j] = v[j] * rstd * g; }
}

__device__ __forceinline__ void p0_prologue(Frame& F) {
    const int tid = F.tid, lane = F.lane;
    {
        const float* ck = INF(F, I_CK); const int* pt = (const int*)F.in[I_PT]; float* kms = (float*)(F.ws + WS_KMS);
        LAS f32x4* scr = (LAS f32x4*)(F.lds + RING_OFF);
        const int c4 = tid & 127, rg = tid >> 7;
        for (int u = F.vcu; u < MS * 32; u += F.G) {
            const int s = u >> 5, j = u & 31;
            const int page = pt[s * NPAGES + 2 * j + (rg >> 1)];
            const f32x4* src = (const f32x4*)(ck + ((size_t)page * PAGE + (rg & 1) * 64) * AW) + c4;
            f32x4 acc = (f32x4){0.f, 0.f, 0.f, 0.f};
#pragma unroll 8
            for (int r = 0; r < 64; ++r) acc += __builtin_nontemporal_load(src + (size_t)r * 128);
            scr[rg * 128 + c4] = acc;
            __syncthreads();
            if (tid < 128) { const f32x4 t = (scr[tid] + scr[128 + tid]) + (scr[256 + tid] + scr[384 + tid]); *(f32x4*)(kms + (size_t)u * AW + 4 * tid) = t * (1.0f / 256.0f); }
            __syncthreads();
        }
    }
    LAS float* scr = (LAS float*)(F.lds + RING_OFF + F.wave * 16384);
    const int gw = F.vcu * NWAVES + F.wave, NGW = F.G * NWAVES;
    constexpr int I0 = (D / 64) * (NIN / 32), I1 = (AW / 64) * (D / 32), I2 = (SW / 64) * (D / 32), I3 = (SW / 64) * (SW / 32), I4 = (D / 64) * (D / 32), I5 = (D / 64) * (2 * FF / 32), I6 = (FF / 64) * (D / 32);
    constexpr int NITEMS = I0 + I1 + I2 + I3 + I4 + I5 + I6;
    for (int it = gw; it < NITEMS; it += NGW) {
        int r = it;
        if (r < I0) { p0_transpose_item<1>(INF(F, I_WIN), D, NIN, (bf16*)(F.ws + WS_WIN), scr, r, lane); continue; } r -= I0;
        if (r < I1) { p0_transpose_item<0>(INF(F, I_WA), AW, D, (bf16*)(F.ws + WS_WA), scr, r, lane); continue; } r -= I1;
        if (r < I2) { p0_transpose_item<0>(INF(F, I_WSP), SW, D, (bf16*)(F.ws + WS_WSP), scr, r, lane); continue; } r -= I2;
        if (r < I3) { p0_transpose_item<0>(INF(F, I_WGLU), SW, SW, (bf16*)(F.ws + WS_WGLU), scr, r, lane); continue; } r -= I3;
        if (r < I4) { p0_transpose_item<0>(INF(F, I_WOUT), D, D, (bf16*)(F.ws + WS_WOUT), scr, r, lane); continue; } r -= I4;
        if (r < I5) { p0_transpose_item<2>(INF(F, I_WFI), D, 2 * FF, (bf16*)(F.ws + WS_WFI), scr, r, lane); continue; } r -= I5;
        p0_transpose_item<0>(INF(F, I_WFO), FF, D, (bf16*)(F.ws + WS_WFO), scr, r, lane);
    }
    for (int m = gw; m < M + MS; m += NGW) {
        const float* xr = m < M ? INF(F, I_XP) + (size_t)m * D : INF(F, I_XS) + (size_t)(m - M) * D;
        rms_row_to_bf16(xr, INF(F, I_NMIX), (bf16*)(F.ws + WS_XN) + (size_t)m * D, lane);
    }
    for (int idx = gw * 64 + lane; idx < 4097 * 32; idx += NGW * 64) {
        const int pidx = idx >> 5, i = idx & 31; const double pos = pidx == 4096 ? 8192.0 : (double)pidx;
        const double ang = pos * ROPE_INV[i]; const double kq = __builtin_rint(ang * 0.15915494309189535);
        const double rr = __builtin_fma(-kq, 6.283185307179586, ang) - kq * 2.4492935982947064e-16;
        float sn, cs; sincosf((float)rr, &sn, &cs);
        ((f32x2*)(F.ws + WS_ROPE))[idx] = (f32x2){cs, sn};
    }
    unsigned char* sc = F.ws + WS_SSMC;
    for (int idx = gw * 64 + lane; idx < NG * NP; idx += NGW * 64) {
        const int g = idx >> 6, p = idx & 63;
        const float dt = expf(INF(F, I_LDT)[g]); const float lr = INF(F, I_ARE)[idx], li = INF(F, I_AIM)[idx];
        const float zr = lr * dt, zi = li * dt; const float er = expf(zr); float sn, cs; sincosf(zi, &sn, &cs);
        const float ar = er * cs, ai = er * sn;
        const float sh = sinf(0.5f * zi); const float nr = expm1f(zr) * cs - 2.0f * sh * sh, ni = ai;
        const float den = lr * lr + li * li; const float cr = (nr * lr + ni * li) / den, ci = (ni * lr - nr * li) / den;
        ((f32x2*)(sc + SC_ABAR))[idx] = (f32x2){ar, ai};
        float tr = ar, ti = ai;
#pragma unroll
        for (int q = 0; q < 8; ++q) { const float n0 = tr * tr - ti * ti, n1 = 2.0f * tr * ti; tr = n0; ti = n1; }
        ((f32x2*)(sc + SC_AT))[idx] = (f32x2){tr, ti};
        const float* br = INF(F, I_BRE) + (size_t)idx * NC; const float* bi = INF(F, I_BIM) + (size_t)idx * NC;
        const int blk = p >> 4, pl = p & 15;
#pragma unroll
        for (int fq = 0; fq < 4; ++fq) { f32x4 re4, im4;
#pragma unroll
            for (int e = 0; e < 4; ++e) { const int c = 4 * fq + e; const float b0 = br[c], b1 = bi[c]; re4[e] = cr * b0 - ci * b1; im4[e] = cr * b1 + ci * b0;
                ((f32x2*)(sc + SC_BBARF))[(size_t)idx * NC + c] = (f32x2){re4[e], im4[e]}; }
            ((u32x2*)(sc + SC_BFRAG))[((g * 4 + blk) * 2 + 0) * 64 + fq * 16 + pl] = pack4(re4);
            ((u32x2*)(sc + SC_BFRAG))[((g * 4 + blk) * 2 + 1) * 64 + fq * 16 + pl] = pack4(im4); }
    }
    for (int idx = gw * 64 + lane; idx < NG * 4 * 64; idx += NGW * 64) {
        const int g = idx >> 8, ks = (idx >> 6) & 3, l2 = idx & 63, c = l2 & 15, fq = l2 >> 4;
        const float* cre = INF(F, I_CRE) + ((size_t)g * NC + c) * NP; const float* cim = INF(F, I_CIM) + ((size_t)g * NC + c) * NP;
        const int p0 = 16 * ks + 4 * fq; v4u o;
        o.x = pk2(cre[p0], -cim[p0]); o.y = pk2(cre[p0 + 1], -cim[p0 + 1]); o.z = pk2(cre[p0 + 2], -cim[p0 + 2]); o.w = pk2(cre[p0 + 3], -cim[p0 + 3]);
        ((v4u*)(sc + SC_CFRAG))[idx] = o;
    }
}

__device__ __forceinline__ void p2_kmean_prompt(Frame& F) {
    const int tid = F.tid; LAS f32x4* scr = (LAS f32x4*)(F.lds + RING_OFF);
    const int c4 = tid & 31, rg = tid >> 5;
    for (int u = F.vcu; u < 256; u += F.G) {
        const int b = u >> 6, j = (u >> 2) & 15, cq = u & 3;
        const f32x4* src = (const f32x4*)(F.out + OUT_KP + ((size_t)b * SEQ + j * 256 + rg * 16) * AW + cq * 128) + c4;
        f32x4 acc = (f32x4){0.f, 0.f, 0.f, 0.f};
#pragma unroll
        for (int r = 0; r < 16; ++r) acc += src[(size_t)r * 128];
        scr[rg * 32 + c4] = acc;
        __syncthreads();
        if (tid < 32) { f32x4 t = scr[tid];
#pragma unroll
            for (int r = 1; r < 16; ++r) t += scr[r * 32 + tid];
            *(f32x4*)((float*)(F.ws + WS_KMP) + ((size_t)b * 16 + j) * AW + cq * 128 + 4 * tid) = t * (1.0f / 256.0f); }
        __syncthreads();
    }
}
template <bool FINAL> __device__ __forceinline__ void s5_unit(Frame& F, int b, int chunk, int g) {
    const int lane = F.lane, fr = lane & 15, fq = lane >> 4;
    LAS float* BU = (LAS float*)(F.lds + RING_OFF + F.wave * 12800);
    LAS bf16* HB = (LAS bf16*)(F.lds + RING_OFF + F.wave * 12800 + 8448);
    const unsigned char* sc = F.ws + WS_SSMC;
    const f32x2 a = ((const f32x2*)(sc + SC_ABAR))[g * 64 + lane];
    s16x4 bfr[4][2];
#pragma unroll
    for (int blk = 0; blk < 4; ++blk)
#pragma unroll
        for (int ri = 0; ri < 2; ++ri) bfr[blk][ri] = ((const s16x4*)(sc + SC_BFRAG))[((g * 4 + blk) * 2 + ri) * 64 + lane];
    bf16x8 cfr[4]; f32x4 dv = (f32x4){0.f, 0.f, 0.f, 0.f};
    if constexpr (FINAL) {
#pragma unroll
        for (int ks = 0; ks < 4; ++ks) cfr[ks] = ((const bf16x8*)(sc + SC_CFRAG))[(g * 4 + ks) * 64 + lane];
        dv = *(const f32x4*)(INF(F, I_SD) + g * 16 + 4 * fq);
    }
    float hr = 0.f, hi = 0.f;
    if constexpr (FINAL) {
        if (chunk > 0) {
            const f32x2 aT = ((const f32x2*)(sc + SC_AT))[g * 64 + lane]; const f32x2* E = (const f32x2*)(F.ws + WS_SSE) + ((size_t)(b * 16) * NG + g) * NP + lane;
            for (int j = 0; j < chunk; ++j) { const f32x2 e = E[(size_t)j * NG * NP]; const float nr = aT.x * hr - aT.y * hi + e.x, ni = aT.x * hi + aT.y * hr + e.y; hr = nr; hi = ni; }
        }
    }
    const size_t row0 = (size_t)b * SEQ + chunk * 256;
    const float* U = (const float*)(F.ws + WS_U); bf16* Z = (bf16*)(F.ws + WS_Z);
    for (int s16 = 0; s16 < 16; ++s16) {
        const size_t row = row0 + s16 * 16 + fr;
        const f32x4 uv = *(const f32x4*)(U + row * SW + g * 16 + 4 * fq);
        const s16x4 ub = __builtin_bit_cast(s16x4, pack4(uv));
#pragma unroll
        for (int blk = 0; blk < 4; ++blk)
#pragma unroll
            for (int ri = 0; ri < 2; ++ri) {
                const f32x4 acc = __builtin_amdgcn_mfma_f32_16x16x16bf16_1k(bfr[blk][ri], ub, (f32x4){0.f, 0.f, 0.f, 0.f}, 0, 0, 0);
                *(LAS f32x4*)(BU + fr * 132 + ri * 64 + blk * 16 + 4 * fq) = acc;
            }
        LDS_WAIT();
#pragma unroll
        for (int t = 0; t < 16; ++t) {
            const float re = BU[t * 132 + lane], im = BU[t * 132 + 64 + lane];
            const float nr = a.x * hr - a.y * hi + re, ni = a.x * hi + a.y * hr + im; hr = nr; hi = ni;
            if constexpr (FINAL) *(LAS unsigned*)(HB + t * 136 + 2 * lane) = pk2(hr, hi);
        }
        if constexpr (FINAL) {
            LDS_WAIT();
            f32x4 y = (f32x4){0.f, 0.f, 0.f, 0.f};
#pragma unroll
            for (int ks = 0; ks < 4; ++ks) { const bf16x8 hf = *(const LAS bf16x8*)(HB + fr * 136 + 32 * ks + 8 * fq); y = __builtin_amdgcn_mfma_f32_16x16x32_bf16(cfr[ks], hf, y, 0, 0, 0); }
            y = y + dv * uv; f32x4 z;
#pragma unroll
            for (int e = 0; e < 4; ++e) z[e] = gelu_tanh(y[e]);
            *(u32x2*)(Z + row * SW + g * 16 + 4 * fq) = pack4(z);
        }
        LDS_WAIT();
    }
    if constexpr (!FINAL) { ((f32x2*)(F.ws + WS_SSE))[(((size_t)b * 16 + chunk) * NG + g) * NP + lane] = (f32x2){hr, hi}; }
    else if (chunk == 15) { F.out[OUT_RP + ((size_t)b * NG + g) * NP + lane] = hr; F.out[OUT_IP + ((size_t)b * NG + g) * NP + lane] = hi; }
}
template <bool FINAL> __device__ __forceinline__ void s5_pass(Frame& F) {
    for (int u = F.vcu; u < 256; u += F.G) {
        const int b = u >> 6, chunk = (u >> 2) & 15, g = (u & 3) * 8 + F.wave;
        if (!FINAL && chunk == 15) continue;
        s5_unit<FINAL>(F, b, chunk, g);
    }
}
__device__ __forceinline__ void s5_sample(Frame& F) {
    const int lane = F.lane; const unsigned char* sc = F.ws + WS_SSMC;
    const int gw = F.vcu * NWAVES + F.wave, NGW = F.G * NWAVES;
    for (int u = gw; u < MS * NG; u += NGW) {
        const int s = u >> 5, g = u & 31;
        const float* urow = (const float*)(F.ws + WS_U) + (size_t)(M + s) * SW + g * 16;
        const f32x2 a = ((const f32x2*)(sc + SC_ABAR))[g * 64 + lane];
        const f32x2* BB = (const f32x2*)(sc + SC_BBARF) + (size_t)(g * 64 + lane) * NC;
        float br = 0.f, bi = 0.f;
#pragma unroll
        for (int c = 0; c < NC; ++c) { const float uc = urow[c]; const f32x2 bb = BB[c]; br += bb.x * uc; bi += bb.y * uc; }
        const float h0r = INF(F, I_SRE)[(size_t)u * NP + lane], h0i = INF(F, I_SIM)[(size_t)u * NP + lane];
        const float hr = a.x * h0r - a.y * h0i + br, hi = a.x * h0i + a.y * h0r + bi;
        F.out[OUT_RS + (size_t)u * NP + lane] = hr; F.out[OUT_IS + (size_t)u * NP + lane] = hi;
        float y = 0.f;
#pragma unroll
        for (int c = 0; c < NC; ++c) { float v = INF(F, I_CRE)[((size_t)g * NC + c) * NP + lane] * hr - INF(F, I_CIM)[((size_t)g * NC + c) * NP + lane] * hi; v = wave_sum(v); if (lane == c) y = v; }
        if (lane < NC) { y += INF(F, I_SD)[g * 16 + lane] * urow[lane]; ((bf16*)(F.ws + WS_Z))[(size_t)(M + s) * SW + g * 16 + lane] = (bf16)f2bf(gelu_tanh(y)); }
    }
}

__device__ __forceinline__ void sample_attn(Frame& F) {
    const int tid = F.tid, lane = F.lane, wave = F.wave;
    LAS float* qs = (LAS float*)(F.lds + RING_OFF);
    LAS float* scr = qs + 64;
    LAS int* pg = (LAS int*)(scr + 832);
    LAS float* wred = (LAS float*)(pg + 8);
    LAS f32x4* red = (LAS f32x4*)(F.lds + RING_OFF + 8192);
    const float* ck = INF(F, I_CK); const float* cv = INF(F, I_CV); const int* pt = (const int*)F.in[I_PT];
    for (int u = F.vcu; u < MS * 8; u += F.G) {
        const int s = u >> 3, h = u & 7;
        bf16* qrow = (bf16*)(F.ws + WS_Q) + (size_t)(M + s) * AW + h * 64;
        if (tid < 64) qs[tid] = bf2f(qrow[tid]);
        __syncthreads();
        if (wave == 0) {
            float val = -INFINITY;
            if (lane < 32) { const f32x4* km = (const f32x4*)((const float*)(F.ws + WS_KMS) + ((size_t)s * 32 + lane) * AW + h * 64); float acc = 0.f;
#pragma unroll
                for (int d = 0; d < 16; ++d) { const f32x4 kv = km[d]; acc += qs[4 * d] * kv[0] + qs[4 * d + 1] * kv[1] + qs[4 * d + 2] * kv[2] + qs[4 * d + 3] * kv[3]; }
                val = acc; }
            for (int r = 0; r < 3; ++r) {
                float m = val;
#pragma unroll
                for (int o = 1; o < 64; o <<= 1) m = fmaxf(m, __shfl_xor(m, o));
                const unsigned long long bal = __ballot(val == m); const int idx = __builtin_ctzll(bal);
                if (lane == 0) { pg[2 * r] = pt[s * NPAGES + 2 * idx]; pg[2 * r + 1] = pt[s * NPAGES + 2 * idx + 1]; }
                if (lane == idx) val = -INFINITY;
            }
        }
        __syncthreads();
        float lmax = -INFINITY;
        for (int kk = tid; kk < 769; kk += 512) {
            const float* kp = kk < 768 ? ck + ((size_t)pg[kk >> 7] * PAGE + (kk & 127)) * AW + h * 64 : F.out + OUT_KS + (size_t)s * AW + h * 64;
            float acc = 0.f;
#pragma unroll
            for (int d = 0; d < 16; ++d) { const f32x4 kv = ((const f32x4*)kp)[d]; acc += qs[4 * d] * kv[0] + qs[4 * d + 1] * kv[1] + qs[4 * d + 2] * kv[2] + qs[4 * d + 3] * kv[3]; }
            scr[kk] = acc; lmax = fmaxf(lmax, acc);
        }
#pragma unroll
        for (int o = 1; o < 64; o <<= 1) lmax = fmaxf(lmax, __shfl_xor(lmax, o));
        if (lane == 0) wred[wave] = lmax;
        __syncthreads();
        float mx = wred[0];
#pragma unroll
        for (int w = 1; w < 8; ++w) mx = fmaxf(mx, wred[w]);
        float lsum = 0.f;
        for (int kk = tid; kk < 769; kk += 512) { const float p = exp2f(scr[kk] - mx); scr[kk] = p; lsum += p; }
        lsum = wave_sum(lsum);
        if (lane == 0) wred[8 + wave] = lsum;
        __syncthreads();
        float l = 0.f;
#pragma unroll
        for (int w = 0; w < 8; ++w) l += wred[8 + w];
        const int d4 = tid & 15, kg = tid >> 4; f32x4 acc = (f32x4){0.f, 0.f, 0.f, 0.f};
        for (int kk = kg; kk < 769; kk += 32) {
            const float* vp = kk < 768 ? cv + ((size_t)pg[kk >> 7] * PAGE + (kk & 127)) * AW + h * 64 : F.out + OUT_VS + (size_t)s * AW + h * 64;
            acc += ((const f32x4*)vp)[d4] * scr[kk];
        }
        red[kg * 16 + d4] = acc;
        __syncthreads();
        if (tid < 64) { float o = 0.f; const LAS float* rf = (const LAS float*)red;
#pragma unroll
            for (int k = 0; k < 32; ++k) o += rf[k * 64 + tid];
            qrow[tid] = (bf16)f2bf(o / l); }
        __syncthreads();
    }
}
__device__ __forceinline__ void norm_x1_to_hf(Frame& F) {
    const int gw = F.vcu * NWAVES + F.wave, NGW = F.G * NWAVES;
    for (int m = gw; m < M + MS; m += NGW) rms_row_to_bf16((const float*)(F.ws + WS_X1) + (size_t)m * D, INF(F, I_NFFN), (bf16*)(F.ws + WS_HF) + (size_t)m * D, F.lane);
}
__device__ __forceinline__ void norm_final(Frame& F) {
    const int gw = F.vcu * NWAVES + F.wave, NGW = F.G * NWAVES;
    for (int m = gw; m < M + MS; m += NGW) { float* r = m < M ? F.out + OUT_Y + (size_t)m * D : F.out + OUT_YS + (size_t)(m - M) * D; rms_row_to_f32(r, INF(F, I_NFIN), r, F.lane); }
}

#ifndef MK_ONE_LAUNCH
#define MK_ONE_LAUNCH 0
#endif
constexpr int N_PHASES = 11;
struct Args { const void* in[N_IN]; float* out; unsigned char* ws; int ph_lo, ph_hi; };
static_assert(sizeof(Args) == N_IN * 8 + 8 + 8 + 8, "no padding in Args");

__global__ void __launch_bounds__(NWAVES * 64, 2) fwd(Args args) {
    extern __shared__ __attribute__((aligned(16))) unsigned char lds[];
    Frame F;
    F.lds = (LAS unsigned char*)lds;
    F.MISC = (volatile LAS unsigned*)(F.lds + MISC_OFF);
    F.tid = threadIdx.x; F.lane = F.tid & 63; F.wave = __builtin_amdgcn_readfirstlane(F.tid >> 6);
    F.G = gridDim.x; { const int bx = blockIdx.x; F.vcu = (F.G % 8 == 0) ? (bx % 8) * (F.G / 8) + bx / 8 : bx; }
    F.in = args.in; F.out = args.out; F.ws = args.ws; F.ctl = (gu32*)(args.ws + WS_CTL);
    for (int u = F.tid; u < (LDS_BYTES - LDSCTL_OFF) / 4; u += NWAVES * 64) ((LAS unsigned*)(F.lds + LDSCTL_OFF))[u] = 0u;
    __syncthreads();
    const int lo = args.ph_lo, hi = args.ph_hi;
    XcdBarrier bar; bar.bar = (unsigned*)(F.ctl + CW_BAR); bar.x = 0; bar.st = nullptr;
    if (hi - lo > 1) bar = xcd_barrier_post((unsigned*)(F.ctl + CW_BAR), F.MISC + 8);
#define IN(k) (lo <= (k) && (k) < hi)
#define BOTH(k) (IN(k) && IN((k) + 1))
#define GRID_BAR() xcd_barrier(bar)
#define REFRESH() do { int t_ = threadIdx.x; asm volatile("" : "+v"(t_)); F.tid = t_; F.lane = t_ & 63; } while (0)
    const EpiCtx ec{INF(F, I_XP), INF(F, I_XS), F.out, F.ws, INF(F, I_BGLU)};
    const bf16* XN = (const bf16*)(F.ws + WS_XN);

    if (IN(0)) { REFRESH(); p0_prologue(F); if (BOTH(0)) GRID_BAR(); }
    if (IN(1)) { REFRESH();
        skinny32<0>(F, ec, XN + (size_t)M * D, D, (const bf16*)(F.ws + WS_WIN), D, NIN);
        pg8::Gemm g{XN, (const bf16*)(F.ws + WS_WIN), M, NIN, D}; pg8::StaticOrder S; S.init(M, NIN, F.G, (int)blockIdx.x);
        EpiG<0> E{ec};
        pg8::gemm_phase<EpiG<0>, pg8::StaticOrder, true, true>(F.lds + RING_OFF, g, S, E);
        if (BOTH(1)) GRID_BAR();
    }
    if (IN(2)) { REFRESH(); p2_kmean_prompt(F); s5_pass<false>(F); if (BOTH(2)) GRID_BAR(); }
    if (IN(3)) { REFRESH();
        const attn_body::AttnTensors AT{(const attn_body::bf16*)(F.ws + WS_Q), (const attn_body::bf16*)(F.ws + WS_K), (const attn_body::bf16*)(F.ws + WS_V), (attn_body::bf16*)(F.ws + WS_Q), (const float*)(F.ws + WS_KMP)};
        const attn_body::StaticOrder S((int)F.G, (int)blockIdx.x);
        attn_body::attn_phase<attn_body::StaticOrder>((char*)lds + RING_OFF, AT, S);
        __syncthreads();
        sample_attn(F);
        s5_pass<true>(F);
        s5_sample(F);
        if (BOTH(3)) GRID_BAR();
    }
    if (IN(4)) { REFRESH();
        skinny32<1>(F, ec, (const bf16*)(F.ws + WS_Z) + (size_t)M * SW, SW, (const bf16*)(F.ws + WS_WGLU), SW, SW);
        skinny32<2>(F, ec, (const bf16*)(F.ws + WS_Q) + (size_t)M * AW, AW, (const bf16*)(F.ws + WS_WA), AW, D);
        { pg8::Gemm g{(const bf16*)(F.ws + WS_Z), (const bf16*)(F.ws + WS_WGLU), M, SW, SW}; pg8::StaticOrder S; S.init(M, SW, F.G, (int)((blockIdx.x + 128u) % gridDim.x));
          EpiG<1> E{ec}; pg8::gemm_phase<EpiG<1>, pg8::StaticOrder, true, true>(F.lds + RING_OFF, g, S, E); }
        { pg8::Gemm g{(const bf16*)(F.ws + WS_Q), (const bf16*)(F.ws + WS_WA), M, D, AW}; pg8::StaticOrder S; S.init(M, D, F.G, (int)blockIdx.x);
          EpiG<2> E{ec}; pg8::gemm_phase<EpiG<2>, pg8::StaticOrder, true, true>(F.lds + RING_OFF, g, S, E); }
        if (BOTH(4)) GRID_BAR();
    }
    if (IN(5)) { REFRESH();
        skinny32<3>(F, ec, (const bf16*)(F.ws + WS_Z2) + (size_t)M * SW, SW, (const bf16*)(F.ws + WS_WSP), SW, D);
        pg8::Gemm g{(const bf16*)(F.ws + WS_Z2), (const bf16*)(F.ws + WS_WSP), M, D, SW}; pg8::StaticOrder S; S.init(M, D, F.G, (int)blockIdx.x);
        EpiG<3> E{ec}; pg8::gemm_phase<EpiG<3>, pg8::StaticOrder, true, true>(F.lds + RING_OFF, g, S, E);
        if (BOTH(5)) GRID_BAR();
    }
    if (IN(6)) { REFRESH();
        skinny32<4>(F, ec, (const bf16*)(F.ws + WS_MG) + (size_t)M * D, D, (const bf16*)(F.ws + WS_WOUT), D, D);
        pg8::Gemm g{(const bf16*)(F.ws + WS_MG), (const bf16*)(F.ws + WS_WOUT), M, D, D}; pg8::StaticOrder S; S.init(M, D, F.G, (int)blockIdx.x);
        EpiG<4> E{ec}; pg8::gemm_phase<EpiG<4>, pg8::StaticOrder, true, true>(F.lds + RING_OFF, g, S, E);
        if (BOTH(6)) GRID_BAR();
    }
    if (IN(7)) { REFRESH(); norm_x1_to_hf(F); if (BOTH(7)) GRID_BAR(); }
    if (IN(8)) { REFRESH();
        skinny32<5>(F, ec, (const bf16*)(F.ws + WS_HF) + (size_t)M * D, D, (const bf16*)(F.ws + WS_WFI), D, 2 * FF);
        pg8::Gemm g{(const bf16*)(F.ws + WS_HF), (const bf16*)(F.ws + WS_WFI), M, 2 * FF, D}; pg8::StaticOrder S; S.init(M, 2 * FF, F.G, (int)blockIdx.x);
        EpiG<5> E{ec}; pg8::gemm_phase<EpiG<5>, pg8::StaticOrder, true, true>(F.lds + RING_OFF, g, S, E);
        if (BOTH(8)) GRID_BAR();
    }
    if (IN(9)) { REFRESH();
        skinny32<6>(F, ec, (const bf16*)(F.ws + WS_H) + (size_t)M * FF, FF, (const bf16*)(F.ws + WS_WFO), FF, D);
        pg8::Gemm g{(const bf16*)(F.ws + WS_H), (const bf16*)(F.ws + WS_WFO), M, D, FF}; pg8::StaticOrder S; S.init(M, D, F.G, (int)blockIdx.x);
        EpiG<6> E{ec}; pg8::gemm_phase<EpiG<6>, pg8::StaticOrder, true, true>(F.lds + RING_OFF, g, S, E);
        if (BOTH(9)) GRID_BAR();
    }
    if (IN(10)) { REFRESH(); norm_final(F); }
#undef IN
#undef BOTH
#undef GRID_BAR
}

extern "C" void kernel_launch(void* const* d_in, const int* in_sizes, int n_in, void* d_out, int out_size, void* d_ws, size_t ws_size, hipStream_t stream) {
    static int grid = 0;
    if (grid == 0) {
        if (n_in != N_IN || out_size != (int)OUT_TOTAL || ws_size < WS_END) { fprintf(stderr, "kernel_launch: unexpected shapes (n_in %d, out %d, ws %zu); nothing launched\n", n_in, out_size, ws_size); grid = -1; return; }
        int dev = 0, cus = 0, per_cu = 0;
        if (hipGetDevice(&dev) != hipSuccess || hipDeviceGetAttribute(&cus, hipDeviceAttributeMultiprocessorCount, dev) != hipSuccess) { grid = -1; return; }
        if (hipFuncSetAttribute((const void*)fwd, hipFuncAttributeMaxDynamicSharedMemorySize, LDS_BYTES) != hipSuccess) { fprintf(stderr, "kernel_launch: hipFuncSetAttribute failed\n"); grid = -1; return; }
        if (hipOccupancyMaxActiveBlocksPerMultiprocessor(&per_cu, (const void*)fwd, NWAVES * 64, LDS_BYTES) != hipSuccess || per_cu < 1) { fprintf(stderr, "kernel_launch: occupancy query reports %d blocks per CU\n", per_cu); }
        (void)hipGetLastError();
        grid = cus;
    }
    if (grid < 0) return;
    (void)hipMemsetAsync((char*)d_ws + WS_CTL, 0, CTL_ZERO_BYTES, stream);
    Args a{};
    for (int i = 0; i < N_IN; ++i) a.in[i] = d_in[i];
    a.out = (float*)d_out; a.ws = (unsigned char*)d_ws;
#if MK_ONE_LAUNCH
    a.ph_lo = 0; a.ph_hi = N_PHASES;
    hipLaunchKernelGGL(fwd, dim3(grid), dim3(NWAVES * 64), LDS_BYTES, stream, a);
#else
    for (int p = 0; p < N_PHASES; ++p) { a.ph_lo = p; a.ph_hi = p + 1; hipLaunchKernelGGL(fwd, dim3(grid), dim3(NWAVES * 64), LDS_BYTES, stream, a); }
#endif
}
```
